# Optimizing an MI355X kernel written in HIP

```python
import math
import jax, jax.numpy as jnp
from jax import lax
import numpy as np

D_MODEL = 1024
BATCH = 16
SEQ = 2048
DEPTH = 4

HEAD_DIM = 64
EPS = 1e-6
Q_BLOCK = 128
MOBA_HEADS = D_MODEL // 2 // HEAD_DIM
FOX_HEADS = D_MODEL // 2 // HEAD_DIM
MOBA_BLOCK = 256
MOBA_TOPK = 3
MOBA_Q_CHUNK = 16
DIFF_V_DIM = 2 * HEAD_DIM
DIFF_HEADS = D_MODEL // 2 // DIFF_V_DIM
SWA_Q_HEADS = D_MODEL // 2 // HEAD_DIM
SWA_KV_HEADS = SWA_Q_HEADS // 4
SWA_WINDOW = 128

N_AB = (DEPTH + 1) // 2
N_CD = DEPTH // 2

MOBA_W = MOBA_HEADS * HEAD_DIM
FOX_W = FOX_HEADS * HEAD_DIM
AB_SIZES = [MOBA_W, MOBA_W, MOBA_W, MOBA_W, FOX_W, FOX_W, FOX_W, FOX_W, FOX_HEADS]
AB_IN = sum(AB_SIZES)
DIFF_QK_W = DIFF_HEADS * 2 * HEAD_DIM
DIFF_W = DIFF_HEADS * DIFF_V_DIM
SWA_W = SWA_Q_HEADS * HEAD_DIM
SWA_KV_W = SWA_KV_HEADS * HEAD_DIM
CD_SIZES = [DIFF_QK_W, DIFF_QK_W, DIFF_W, DIFF_W, SWA_W, SWA_KV_W, SWA_KV_W, SWA_W]
CD_IN = sum(CD_SIZES)
MIX_W = D_MODEL

kernel_name = "hybrid_moba_fox_diff_swa_gated"


def rmsnorm(x, gain):
    xf = x.astype(jnp.float32)
    y = xf * lax.rsqrt(jnp.mean(xf * xf, axis=-1, keepdims=True) + EPS)
    return (y * gain.astype(jnp.float32)).astype(x.dtype)


def alibi_slopes(n):
    return jnp.asarray(2.0 ** (-8.0 * np.arange(1, n + 1) / n), dtype=jnp.float32)


def split_cols(t, sizes):
    idx = np.cumsum(sizes)[:-1].tolist()
    return jnp.split(t, idx, axis=-1)


def to_heads(t, n):
    b, s, _ = t.shape
    return t.reshape(b, s, n, -1).transpose(0, 2, 1, 3)


def from_heads(t):
    b, h, s, d = t.shape
    return t.transpose(0, 2, 1, 3).reshape(b, s, h * d)


def moba_attention(q, k, v, slopes):
    B, H, S, Dh = q.shape
    L = MOBA_BLOCK
    nb = -(-S // L)
    pad = nb * L - S
    kp = jnp.pad(k, ((0, 0), (0, 0), (0, pad), (0, 0)))
    vp = jnp.pad(v, ((0, 0), (0, 0), (0, pad), (0, 0)))
    kb = kp.reshape(B, H, nb, L, Dh)
    vb = vp.reshape(B, H, nb, L, Dh)
    kmean = jnp.mean(kb.astype(jnp.float32), axis=3)
    pos = jnp.arange(S)
    qblk = pos // L
    gate = jnp.einsum('bhsd,bhnd->bhsn', q.astype(jnp.float32), kmean)
    past = jnp.arange(nb)[None, :] < qblk[:, None]
    gate = jnp.where(past, gate, -jnp.inf)
    topk = min(MOBA_TOPK, nb)
    _, sel = lax.top_k(gate, topk)
    sel_valid = sel < qblk[None, None, :, None]
    scale = Dh ** -0.5
    bi = jnp.arange(B)[:, None, None, None]
    hi = jnp.arange(H)[None, :, None, None]
    C = MOBA_Q_CHUNK

    def chunk(c):
        start = c * C
        qc = lax.dynamic_slice_in_dim(q, start, C, axis=2)
        selc = lax.dynamic_slice_in_dim(sel, start, C, axis=2)
        validc = lax.dynamic_slice_in_dim(sel_valid, start, C, axis=2)
        tpos = start + jnp.arange(C)
        kg = kb[bi, hi, selc]
        vg = vb[bi, hi, selc]
        s_past = jnp.einsum('bhqd,bhqnld->bhqnl', qc, kg).astype(jnp.float32) * scale
        spos = selc[..., None] * L + jnp.arange(L)
        rel_p = (tpos[None, None, :, None, None] - spos).astype(jnp.float32)
        s_past = jnp.where(validc[..., None],
                           s_past - slopes[None, :, None, None, None] * rel_p, -jnp.inf)
        s_past = s_past.reshape(B, H, C, topk * L)
        own_start = (start // L) * L
        ko = lax.dynamic_slice_in_dim(kp, own_start, L, axis=2)
        vo = lax.dynamic_slice_in_dim(vp, own_start, L, axis=2)
        s_own = jnp.einsum('bhqd,bhld->bhql', qc, ko).astype(jnp.float32) * scale
        rel_o = tpos[:, None] - (own_start + jnp.arange(L))[None, :]
        s_own = jnp.where(rel_o >= 0,
                          s_own - slopes[None, :, None, None] * rel_o.astype(jnp.float32),
                          -jnp.inf)
        p = jax.nn.softmax(jnp.concatenate([s_past, s_own], axis=-1), axis=-1).astype(v.dtype)
        p_past = p[..., :topk * L].reshape(B, H, C, topk, L)
        p_own = p[..., topk * L:]
        return (jnp.einsum('bhqnl,bhqnld->bhqd', p_past, vg)
                + jnp.einsum('bhql,bhld->bhqd', p_own, vo))

    outs = lax.map(chunk, jnp.arange(S // C))
    return outs.transpose(1, 2, 0, 3, 4).reshape(B, H, S, Dh)


def fox_attention(q, k, v, log_f):
    B, H, S, Dh = q.shape
    c = jnp.cumsum(log_f, axis=-1)
    scale = Dh ** -0.5
    kpos = jnp.arange(S)

    def block(i):
        start = i * Q_BLOCK
        qb = lax.dynamic_slice_in_dim(q, start, Q_BLOCK, axis=2)
        cb = lax.dynamic_slice_in_dim(c, start, Q_BLOCK, axis=2)
        s = (jnp.einsum('bhqd,bhsd->bhqs', qb, k).astype(jnp.float32) * scale
             + cb[..., None] - c[:, :, None, :])
        tpos = start + jnp.arange(Q_BLOCK)
        s = jnp.where(tpos[:, None] >= kpos[None, :], s, -jnp.inf)
        p = jax.nn.softmax(s, axis=-1).astype(v.dtype)
        return jnp.einsum('bhqs,bhsd->bhqd', p, v)

    outs = lax.map(block, jnp.arange(S // Q_BLOCK))
    return outs.transpose(1, 2, 0, 3, 4).reshape(B, H, S, Dh)


def diff_attention(q, k, v, lam, slopes):
    B, H, S, _, Dh = q.shape
    scale = Dh ** -0.5
    kpos = jnp.arange(S)

    def block(i):
        start = i * Q_BLOCK
        qb = lax.dynamic_slice_in_dim(q, start, Q_BLOCK, axis=2)
        s = jnp.einsum('bhqcd,bhscd->bhcqs', qb, k).astype(jnp.float32) * scale
        rel = (start + jnp.arange(Q_BLOCK))[:, None] - kpos[None, :]
        s = jnp.where(rel >= 0,
                      s - slopes[None, :, None, None, None] * rel.astype(jnp.float32),
                      -jnp.inf)
        p = jax.nn.softmax(s, axis=-1)
        a = (p[:, :, 0] - lam * p[:, :, 1]).astype(v.dtype)
        return jnp.einsum('bhqs,bhse->bhqe', a, v)

    outs = lax.map(block, jnp.arange(S // Q_BLOCK))
    return outs.transpose(1, 2, 0, 3, 4).reshape(B, H, S, v.shape[-1])


def swa_attention(q, k, v, sinks, slopes):
    B, S, Hq, Dh = q.shape
    Hkv = k.shape[2]
    G = Hq // Hkv
    nb = S // Q_BLOCK
    qb = q.reshape(B, nb, Q_BLOCK, Hkv, G, Dh)
    kb = k.reshape(B, nb, Q_BLOCK, Hkv, Dh)
    vb = v.reshape(B, nb, Q_BLOCK, Hkv, Dh)
    pad = ((0, 0), (1, 0), (0, 0), (0, 0), (0, 0))
    kband = jnp.concatenate([jnp.pad(kb, pad)[:, :-1], kb], axis=2)
    vband = jnp.concatenate([jnp.pad(vb, pad)[:, :-1], vb], axis=2)
    s = jnp.einsum('bnqgrd,bnkgd->bngrqk', qb, kband).astype(jnp.float32) * (Dh ** -0.5)
    qi = jnp.arange(Q_BLOCK)
    ki = jnp.arange(2 * Q_BLOCK)
    rel = (Q_BLOCK + qi)[:, None] - ki[None, :]
    in_win = (rel >= 0) & (rel < SWA_WINDOW)
    has_prev = (jnp.arange(nb) > 0)[:, None, None] | (ki >= Q_BLOCK)[None, None, :]
    mask = in_win[None] & has_prev
    bias = -slopes.reshape(Hkv, G)[:, :, None, None] * rel.astype(jnp.float32)
    s = jnp.where(mask[None, :, None, None], s + bias, -jnp.inf)
    sink = jnp.broadcast_to(
        sinks.astype(jnp.float32).reshape(Hkv, G)[None, None, :, :, None, None],
        s.shape[:-1] + (1,))
    p = jax.nn.softmax(jnp.concatenate([s, sink], axis=-1), axis=-1)[..., :-1]
    out = jnp.einsum('bngrqk,bnkgd->bnqgrd', p.astype(v.dtype), vband)
    return out.reshape(B, S, Hq * Dh)


def setup_inputs(seed: int = 0) -> dict:
    key = jax.random.key(seed)
    ks = jax.random.split(key, 20)
    f32 = jnp.float32
    nrm = lambda k, shp: jax.random.normal(k, shp, f32)
    gain = lambda k, shp: 1.0 + 0.05 * nrm(k, shp)
    return {
        "x": nrm(ks[0], (BATCH, SEQ, D_MODEL)),
        "norm_gain": gain(ks[1], (DEPTH, D_MODEL)),
        "w_in_ab": nrm(ks[2], (N_AB, D_MODEL, AB_IN)) * D_MODEL ** -0.5,
        "b_forget": 3.0 + 0.3 * nrm(ks[3], (N_AB, FOX_HEADS)),
        "moba_q_gain": gain(ks[4], (N_AB, HEAD_DIM)),
        "moba_k_gain": gain(ks[5], (N_AB, HEAD_DIM)),
        "fox_q_gain": gain(ks[6], (N_AB, HEAD_DIM)),
        "fox_k_gain": gain(ks[7], (N_AB, HEAD_DIM)),
        "w_out_ab": nrm(ks[8], (N_AB, MIX_W, D_MODEL)) * MIX_W ** -0.5,
        "w_in_cd": nrm(ks[9], (N_CD, D_MODEL, CD_IN)) * D_MODEL ** -0.5,
        "diff_q_gain": gain(ks[10], (N_CD, HEAD_DIM)),
        "diff_k_gain": gain(ks[11], (N_CD, HEAD_DIM)),
        "diff_lambda": 0.1 * nrm(ks[12], (N_CD, 4, HEAD_DIM)),
        "diff_subln_gain": gain(ks[13], (N_CD, DIFF_V_DIM)),
        "swa_q_gain": gain(ks[14], (N_CD, HEAD_DIM)),
        "swa_k_gain": gain(ks[15], (N_CD, HEAD_DIM)),
        "swa_sinks": nrm(ks[16], (N_CD, SWA_Q_HEADS)),
        "w_out_cd": nrm(ks[17], (N_CD, MIX_W, D_MODEL)) * MIX_W ** -0.5,
    }


def reference(x, norm_gain, w_in_ab, b_forget, moba_q_gain, moba_k_gain, fox_q_gain,
              fox_k_gain, w_out_ab, w_in_cd, diff_q_gain, diff_k_gain, diff_lambda,
              diff_subln_gain, swa_q_gain, swa_k_gain, swa_sinks, w_out_cd):
    B, S, _ = x.shape
    moba_slopes = alibi_slopes(MOBA_HEADS)
    diff_slopes = alibi_slopes(DIFF_HEADS)
    swa_slopes = alibi_slopes(SWA_Q_HEADS)
    for layer in range(DEPTH):
        h = rmsnorm(x, norm_gain[layer])
        j = layer // 2
        if layer % 2 == 0:
            proj = h @ w_in_ab[j]
            qa, ka, va, ga, qb, kb_, vb_, gb, fb = split_cols(proj, AB_SIZES)
            qa = rmsnorm(to_heads(qa, MOBA_HEADS), moba_q_gain[j])
            ka = rmsnorm(to_heads(ka, MOBA_HEADS), moba_k_gain[j])
            ya = from_heads(moba_attention(qa, ka, to_heads(va, MOBA_HEADS), moba_slopes))
            qb = rmsnorm(to_heads(qb, FOX_HEADS), fox_q_gain[j])
            kb_ = rmsnorm(to_heads(kb_, FOX_HEADS), fox_k_gain[j])
            log_f = jax.nn.log_sigmoid(fb.astype(jnp.float32)
                                       + b_forget[j].astype(jnp.float32)).transpose(0, 2, 1)
            yb = from_heads(fox_attention(qb, kb_, to_heads(vb_, FOX_HEADS), log_f))
            y = jnp.concatenate([ya * jax.nn.silu(ga), yb * jax.nn.silu(gb)], axis=-1)
            x = x + y @ w_out_ab[j]
        else:
            proj = h @ w_in_cd[j]
            qc, kc, vc, gc, qd, kd, vd, gd = split_cols(proj, CD_SIZES)
            qc = rmsnorm(qc.reshape(B, S, DIFF_HEADS, 2, HEAD_DIM).transpose(0, 2, 1, 3, 4),
                         diff_q_gain[j])
            kc = rmsnorm(kc.reshape(B, S, DIFF_HEADS, 2, HEAD_DIM).transpose(0, 2, 1, 3, 4),
                         diff_k_gain[j])
            lam_init = 0.8 - 0.6 * math.exp(-0.3 * layer)
            lp = diff_lambda[j].astype(jnp.float32)
            lam = (jnp.exp(jnp.sum(lp[0] * lp[1])) - jnp.exp(jnp.sum(lp[2] * lp[3]))
                   + lam_init)
            oc = diff_attention(qc, kc, to_heads(vc, DIFF_HEADS), lam, diff_slopes)
            oc = rmsnorm(oc, diff_subln_gain[j]) * (1.0 - lam_init)
            yc = from_heads(oc)
            qd = rmsnorm(qd.reshape(B, S, SWA_Q_HEADS, HEAD_DIM), swa_q_gain[j])
            kd = rmsnorm(kd.reshape(B, S, SWA_KV_HEADS, HEAD_DIM), swa_k_gain[j])
            vd = vd.reshape(B, S, SWA_KV_HEADS, HEAD_DIM)
            yd = swa_attention(qd, kd, vd, swa_sinks[j], swa_slopes)
            y = jnp.concatenate([yc * jax.nn.silu(gc), yd * jax.nn.silu(gd)], axis=-1)
            x = x + y @ w_out_cd[j]
    return x
```

```cpp
#include <hip/hip_runtime.h>
#include <hip/hip_cooperative_groups.h>
#include <cstdio>
#include <cstdint>
namespace cg = cooperative_groups;
#ifndef EN
#define EN 0xff
#endif

constexpr int BATCH = 16, SEQ = 2048, DM = 1024, MTOK = BATCH * SEQ;
constexpr int AB_N = 4096, AB_SRC = 4104, CD_N = 3328;
constexpr float EPS = 1e-6f;
constexpr float LOG2E = 1.4426950408889634f;
constexpr float QSCALE = 0.125f * LOG2E;
__device__ __forceinline__ int opaque_tid() { int t = (int)threadIdx.x; asm volatile("" : "+v"(t)); return t; }

typedef unsigned xl_u2 __attribute__((ext_vector_type(2)));
template <int CTRL> __device__ __forceinline__ float dppf(float x) { return __int_as_float(__builtin_amdgcn_update_dpp(0, __float_as_int(x), CTRL, 0xf, 0xf, false)); }
__device__ __forceinline__ float rsum16(float x) { x += dppf<0x128>(x); x += dppf<0x124>(x); x += dppf<0x122>(x); x += dppf<0x121>(x); return x; }
__device__ __forceinline__ float rmax16(float x) { x = fmaxf(x, dppf<0x128>(x)); x = fmaxf(x, dppf<0x124>(x)); x = fmaxf(x, dppf<0x122>(x)); x = fmaxf(x, dppf<0x121>(x)); return x; }
__device__ __forceinline__ float rmin16(float x) { x = fminf(x, dppf<0x128>(x)); x = fminf(x, dppf<0x124>(x)); x = fminf(x, dppf<0x122>(x)); x = fminf(x, dppf<0x121>(x)); return x; }
__device__ __forceinline__ float xadd32(float x) { const xl_u2 r = __builtin_amdgcn_permlane32_swap(__float_as_uint(x), __float_as_uint(x), false, false); return __uint_as_float(r[0]) + __uint_as_float(r[1]); }
__device__ __forceinline__ float xadd16(float x) { const xl_u2 r = __builtin_amdgcn_permlane16_swap(__float_as_uint(x), __float_as_uint(x), false, false); return __uint_as_float(r[0]) + __uint_as_float(r[1]); }
__device__ __forceinline__ float xmax32(float x) { const xl_u2 r = __builtin_amdgcn_permlane32_swap(__float_as_uint(x), __float_as_uint(x), false, false); return fmaxf(__uint_as_float(r[0]), __uint_as_float(r[1])); }
__device__ __forceinline__ float xmax16(float x) { const xl_u2 r = __builtin_amdgcn_permlane16_swap(__float_as_uint(x), __float_as_uint(x), false, false); return fmaxf(__uint_as_float(r[0]), __uint_as_float(r[1])); }
__device__ __forceinline__ float xmin16(float x) { const xl_u2 r = __builtin_amdgcn_permlane16_swap(__float_as_uint(x), __float_as_uint(x), false, false); return fminf(__uint_as_float(r[0]), __uint_as_float(r[1])); }
namespace pg8 {
#define PG8_LAS __attribute__((address_space(3)))
typedef unsigned short bf16_t;
typedef short bf16x8 __attribute__((ext_vector_type(8)));
typedef float f32x4 __attribute__((ext_vector_type(4)));
typedef unsigned u32x4 __attribute__((ext_vector_type(4)));
constexpr int BM = 256, BK = 64, HALF = 128, HTB = HALF * BK * 2  , STAGE_BYTES = 8 * HTB, NXCD = 8, WGM = 4;

__host__ __device__ __forceinline__ int lds_byte(int r, int c) { const int st = (r >> 4) * 2 + (c >> 5), rr = r & 15, cc = c & 31, ob = rr * 64 + cc * 2; return st * 1024 + (ob ^ (((ob >> 9) & 1) << 5)); }
__host__ __device__ __forceinline__ void stage_rc(int b, int& R, int& C) { const int st = b / 1024, sb = b % 1024, swz = sb ^ (((sb >> 9) & 1) << 5); R = (st >> 1) * 16 + swz / 64; C = (st & 1) * 32 + (swz % 64) / 2; }
__host__ __device__ __forceinline__ int perm32(int rho) { const int n = rho >> 4, i = rho & 15; return 8 * (i >> 2) + 4 * n + (i & 3); }

struct Unit { int pm, pn; };
struct Gemm { const bf16_t* A; const bf16_t* Bt; int M, N, K; };

struct StaticOrder {
    int nM, nN, nwg, G, c;
    __host__ __device__ void init(int M, int N, int G_, int c_) { nM = M / BM; nN = N / BM; nwg = nM * nN; G = G_; c = c_; }
    __host__ __device__ void init_tail(int M, int pn, int G_, int c_) { nM = M / BM; nN = -pn; nwg = nM; G = G_; c = c_; }
    __host__ __device__ bool next(int i, Unit& u) const {
        const long L = (long)i * G + c; if (L >= nwg) return false;
        if (nN < 0) { u.pm = (int)L; u.pn = -nN; return true; }
        int wgid = (int)L; { const int q = nwg / NXCD, r = nwg % NXCD, xcd = wgid % NXCD, off = wgid / NXCD; wgid = (xcd < r ? xcd * (q + 1) : r * (q + 1) + (xcd - r) * q) + off; }
        const int nig = WGM * nN, gid = wgid / nig, fm = gid * WGM, gsz = (nM - fm) < WGM ? (nM - fm) : WGM;
        u.pm = fm + ((wgid % nig) % gsz); u.pn = (wgid % nig) / gsz; return true;
    }
    __device__ __forceinline__ void a_ready(const Unit&) const {}
    __device__ __forceinline__ void done(const Unit&) const {}
};


__device__ __forceinline__ unsigned cvt_pk_bf16(float lo, float hi) { typedef float f2 __attribute__((ext_vector_type(2))); typedef __bf16 b2 __attribute__((ext_vector_type(2))); f2 v = {lo, hi}; b2 b = __builtin_convertvector(v, b2); return __builtin_bit_cast(unsigned, b); }
#define PG8_EPI_BAR() do { asm volatile("s_waitcnt lgkmcnt(0)" ::: "memory"); __builtin_amdgcn_s_barrier(); asm volatile("" ::: "memory"); } while (0)

struct EpiIn {
    static constexpr bool PERM = true, AFTER_DRAIN = false;
    bf16_t* O; int ldc; const float* ssq; int cd;
    const float* gq0; const float* gk0; const float* gq1; const float* gk1;
    float* kmean; PG8_LAS float* rsl;
    __device__ __forceinline__ void prefetch(const Unit& u, int wid, int lane, int par) const {
        if (wid < 4) { unsigned keep; const void* g = ssq + (size_t)(u.pm * BM + wid * 64 + lane) * 4; const unsigned d = (unsigned)(uintptr_t)rsl + par * 4096 + wid * 1024;
            asm volatile("s_mov_b32 %0, m0\n\ts_mov_b32 m0, %2\n\ts_nop 0\n\tglobal_load_lds_dwordx4 %1, off\n\ts_mov_b32 m0, %0" : "=&s"(keep) : "v"(g), "s"(__builtin_amdgcn_readfirstlane((int)d)) : "memory"); }
    }
    template <int T>
    __device__ __forceinline__ void run(const f32x4 (&acc)[2][2][4][2], const Unit& u, int wr, int wc, int fr, int fq, int par, int gi) const {
        f32x4 gv[2][2];
#pragma unroll
        for (int bj = 0; bj < 2; ++bj)
#pragma unroll
            for (int n = 0; n < 2; ++n) gv[bj][n] = (T >= 2) ? *(const PG8_LAS f32x4*)(rsl + 2048 + gi * 64 + 32 * bj + 8 * fq + 4 * n) : (f32x4){1.f, 1.f, 1.f, 1.f};
        constexpr float qs = (T == 2) ? (0.125f * 1.4426950408889634f) : 1.0f;
        f32x4 cs[2][2];
#pragma unroll
        for (int bj = 0; bj < 2; ++bj)
#pragma unroll
            for (int n = 0; n < 2; ++n) cs[bj][n] = (f32x4){0.f, 0.f, 0.f, 0.f};
#pragma unroll
        for (int ai = 0; ai < 2; ++ai)
#pragma unroll
            for (int m = 0; m < 4; ++m) {
                const int rl = ai * HALF + wr * 64 + m * 16 + fr; const f32x4 s4 = *(const PG8_LAS f32x4*)(rsl + par * 1024 + rl * 4);
                const float rs = __builtin_amdgcn_rsqf(((s4[0] + s4[1]) + (s4[2] + s4[3])) * (1.0f / 1024.0f) + 1e-6f);
                f32x4 v[2][2];
                if constexpr (T >= 2) {
                    f32x4 q4 = acc[ai][0][m][0] * acc[ai][0][m][0];
                    q4 += acc[ai][0][m][1] * acc[ai][0][m][1]; q4 += acc[ai][1][m][0] * acc[ai][1][m][0]; q4 += acc[ai][1][m][1] * acc[ai][1][m][1];
                    float ss = (q4[0] + q4[1]) + (q4[2] + q4[3]);
                    ss = xadd16(ss); ss = xadd32(ss);
                    const float inv = rs * __builtin_amdgcn_rsqf(rs * rs * ss * (1.0f / 64.0f) + 1e-6f) * qs;
#pragma unroll
                    for (int bj = 0; bj < 2; ++bj)
#pragma unroll
                        for (int n = 0; n < 2; ++n) v[bj][n] = acc[ai][bj][m][n] * inv * gv[bj][n];
                    if constexpr (T == 4) {
#pragma unroll
                        for (int bj = 0; bj < 2; ++bj)
#pragma unroll
                            for (int n = 0; n < 2; ++n) cs[bj][n] += v[bj][n];
                    }
                } else if constexpr (T == 1) {
                    const float nrs = rs * -1.4426950408889634f;
#pragma unroll
                    for (int bj = 0; bj < 2; ++bj)
#pragma unroll
                        for (int n = 0; n < 2; ++n) { const f32x4 x = acc[ai][bj][m][n] * rs; f32x4 e = acc[ai][bj][m][n] * nrs;
#pragma unroll
                            for (int c = 0; c < 4; ++c) e[c] = __builtin_amdgcn_exp2f(e[c]);
                            e += (f32x4){1.f, 1.f, 1.f, 1.f};
#pragma unroll
                            for (int c = 0; c < 4; ++c) e[c] = __builtin_amdgcn_rcpf(e[c]);
                            v[bj][n] = x * e; }
                } else {
#pragma unroll
                    for (int bj = 0; bj < 2; ++bj)
#pragma unroll
                        for (int n = 0; n < 2; ++n) v[bj][n] = acc[ai][bj][m][n] * rs;
                }
                bf16_t* rowp = O + (size_t)(u.pn * 4 + wc) * ((size_t)32768 * 64) + (size_t)(u.pm * BM + rl) * 64 + 8 * fq;
#pragma unroll
                for (int bj = 0; bj < 2; ++bj) { u32x4 w; w.x = cvt_pk_bf16(v[bj][0][0], v[bj][0][1]); w.y = cvt_pk_bf16(v[bj][0][2], v[bj][0][3]); w.z = cvt_pk_bf16(v[bj][1][0], v[bj][1][1]); w.w = cvt_pk_bf16(v[bj][1][2], v[bj][1][3]);
                    *(u32x4*)(rowp + bj * 32) = w; }
            }
        if constexpr (T == 4) {
            const int head = (u.pn & 1) * 4 + wc;
#pragma unroll
            for (int bj = 0; bj < 2; ++bj)
#pragma unroll
                for (int n = 0; n < 2; ++n)
#pragma unroll
                    for (int e = 0; e < 4; ++e) cs[bj][n][e] = rsum16(cs[bj][n][e]);
            if (fr == 0) { float* kp = kmean + ((size_t)(u.pm * 2 + wr) * 8 + head) * 64 + 8 * fq;
#pragma unroll
                for (int bj = 0; bj < 2; ++bj)
#pragma unroll
                    for (int n = 0; n < 2; ++n) *(f32x4*)(kp + 32 * bj + 4 * n) = cs[bj][n]; }
        }
    }
    __device__ __forceinline__ void operator()(const f32x4 (&acc)[2][2][4][2], const Unit& u, int wr, int wc, int fr, int fq, int par) const {
        int type = 0; int gain = 0;
        if (!cd) { const int seg = u.pn >> 1;
            if (seg == 0) { type = 2; gain = 0; } else if (seg == 1) { type = 4; gain = 1; } else if (seg == 3 || seg == 7) type = 1;
            else if (seg == 4) { type = 2; gain = 2; } else if (seg == 5) { type = 3; gain = 3; } }
        else { const int pn = u.pn;
            if (pn < 2) { type = 2; gain = 0; } else if (pn < 4) { type = 3; gain = 1; } else if (pn < 6) type = 0; else if (pn < 8) type = 1;
            else if (pn < 10) { type = 2; gain = 2; } else if (pn == 10) { if (wc < 2) { type = 3; gain = 3; } } else type = 1; }
        type = __builtin_amdgcn_readfirstlane(type);
        if (type == 0) run<0>(acc, u, wr, wc, fr, fq, par, gain);
        else if (type == 1) run<1>(acc, u, wr, wc, fr, fq, par, gain);
        else if (type == 2) run<2>(acc, u, wr, wc, fr, fq, par, gain);
        else if (type == 3) run<3>(acc, u, wr, wc, fr, fq, par, gain);
        else run<4>(acc, u, wr, wc, fr, fq, par, gain);
    }
};

struct EpiOut {
    static constexpr bool PERM = true, AFTER_DRAIN = false;
    const float* xin; float* xout; bf16_t* xb; float* ssq; PG8_LAS float* part; int layer;
    __device__ __forceinline__ void prefetch(const Unit&, int, int, int) const {}
    template <int KIND>
    __device__ __forceinline__ void run(const f32x4 (&acc)[2][2][4][2], const Unit& u, int wr, int wc, int fr, int fq) const {
        const int tid = opaque_tid();
        const int col0 = u.pn * BM + wc * 32 + 8 * fq;
        constexpr int NB = (KIND == 0) ? 2 : 1, AIB = 2 / NB;
#pragma unroll
        for (int b = 0; b < NB; ++b) {
            f32x4 xf[(KIND == 0) ? 1 : 1][(KIND == 0) ? 4 : 1][2][2]; u32x4 xw[(KIND == 0) ? 1 : 2][4][2];
#pragma unroll
            for (int a = 0; a < AIB; ++a)
#pragma unroll
                for (int m = 0; m < 4; ++m)
#pragma unroll
                    for (int bj = 0; bj < 2; ++bj) { const int ai = b * AIB + a; const size_t off = (size_t)(u.pm * BM + ai * HALF + wr * 64 + m * 16 + fr) * 1024 + col0 + bj * HALF;
                        if constexpr (KIND == 0) { xf[0][m][bj][0] = *(const f32x4*)(xin + off); xf[0][m][bj][1] = *(const f32x4*)(xin + off + 4); }
                        else xw[a][m][bj] = *(const u32x4*)(xb + off); }
            asm volatile("" ::: "memory");
#pragma unroll
            for (int a = 0; a < AIB; ++a)
#pragma unroll
                for (int m = 0; m < 4; ++m) { const int ai = b * AIB + a;
                    const int rl = ai * HALF + wr * 64 + m * 16 + fr; const size_t off = (size_t)(u.pm * BM + rl) * 1024 + col0;
                    float ss = 0.f;
#pragma unroll
                    for (int bj = 0; bj < 2; ++bj) {
                        f32x4 x0, x1;
                        if constexpr (KIND == 0) { x0 = xf[0][m][bj][0]; x1 = xf[0][m][bj][1]; }
                        else { const u32x4 w = xw[a][m][bj];
                            x0 = (f32x4){__uint_as_float(w.x << 16), __uint_as_float(w.x & 0xffff0000u), __uint_as_float(w.y << 16), __uint_as_float(w.y & 0xffff0000u)};
                            x1 = (f32x4){__uint_as_float(w.z << 16), __uint_as_float(w.z & 0xffff0000u), __uint_as_float(w.w << 16), __uint_as_float(w.w & 0xffff0000u)}; }
                        const f32x4 v0 = acc[ai][bj][m][0] + x0, v1 = acc[ai][bj][m][1] + x1;
                        if constexpr (KIND == 2) { *(f32x4*)(xout + off + bj * HALF) = v0; *(f32x4*)(xout + off + bj * HALF + 4) = v1; }
                        else {
                            u32x4 w; w.x = cvt_pk_bf16(v0[0], v0[1]); w.y = cvt_pk_bf16(v0[2], v0[3]); w.z = cvt_pk_bf16(v1[0], v1[1]); w.w = cvt_pk_bf16(v1[2], v1[3]);
                            *(u32x4*)(xb + off + bj * HALF) = w;
                            const float r0 = __uint_as_float(w.x << 16), r1 = __uint_as_float(w.x & 0xffff0000u), r2 = __uint_as_float(w.y << 16), r3 = __uint_as_float(w.y & 0xffff0000u);
                            const float r4 = __uint_as_float(w.z << 16), r5 = __uint_as_float(w.z & 0xffff0000u), r6 = __uint_as_float(w.w << 16), r7 = __uint_as_float(w.w & 0xffff0000u);
                            ss += (r0 * r0 + r1 * r1) + (r2 * r2 + r3 * r3) + (r4 * r4 + r5 * r5) + (r6 * r6 + r7 * r7);
                        }
                    }
                    if constexpr (KIND != 2) { ss = xadd16(ss); ss = xadd32(ss); if (fq == 0) part[rl * 4 + wc] = ss; }
                }
        }
        PG8_EPI_BAR();
        if (KIND != 2 && tid < 256) { const f32x4 p4 = *(const PG8_LAS f32x4*)(part + tid * 4); ssq[(size_t)(u.pm * BM + tid) * 4 + u.pn] = (p4[0] + p4[1]) + (p4[2] + p4[3]); }
    }
    __device__ __forceinline__ void operator()(const f32x4 (&acc)[2][2][4][2], const Unit& u, int wr, int wc, int fr, int fq, int) const {
        if (layer == 0) run<0>(acc, u, wr, wc, fr, fq); else if (layer == 3) run<2>(acc, u, wr, wc, fr, fq); else run<1>(acc, u, wr, wc, fr, fq);
    }
};

template <class Epi, class Sched, bool ALIGN_EPI = false, bool SP2 = false>
__device__ __forceinline__ void gemm_phase(PG8_LAS unsigned char* lds, const Gemm g, const Sched& S, const Epi& E) {
    const int tid = opaque_tid(), wid = __builtin_amdgcn_readfirstlane(tid >> 6), lane = tid & 63, wr = wid >> 2, wc = wid & 3, fr = lane & 15, fq = lane >> 4;
    const int K = g.K, nt = K / BK;
    unsigned voffA[2], voffB[2];
#pragma unroll
    for (int i = 0; i < 2; ++i) { int R, C; stage_rc(tid * 16 + i * 8192, R, C); const int Rb = Epi::PERM ? ((R & ~31) + perm32(R & 31)) : R;
        voffA[i] = (unsigned)(R * K + C) * 2u; voffB[i] = (unsigned)(Rb * K + C) * 2u; }
    const size_t kstep = (size_t)(BK * 2);
    const size_t hstep = (size_t)HALF * K * 2;
    const size_t tstep = 2 * hstep;
    const unsigned ldsw = (unsigned)wid * 1024u;
    const int aoff = lds_byte(wr * 64 + fr, fq * 8), boff = lds_byte(wc * 32 + fr, fq * 8);
#define PG8_SA(b, h) (((b) * 2 + (h)) * HTB)
#define PG8_SB(b, h) ((4 + (b) * 2 + (h)) * HTB)
#define PG8_STAGE(bufoff, gbase, voff) do { _Pragma("unroll") for (int _i = 0; _i < 2; ++_i) \
        __builtin_amdgcn_global_load_lds((const unsigned*)((const char*)(gbase) + (voff)[_i]), (PG8_LAS unsigned*)(lds + (bufoff) + ldsw + _i * 8192), 16, 0, 0); } while (0)
#define PG8_LDA(dst, b, h) do { _Pragma("unroll") for (int m = 0; m < 4; ++m) _Pragma("unroll") for (int k = 0; k < 2; ++k) dst[m][k] = *(const PG8_LAS bf16x8*)(lds + PG8_SA(b, h) + aoff + m * 2048 + k * 1024); } while (0)
#define PG8_LDB(dst, b, h) do { _Pragma("unroll") for (int n = 0; n < 2; ++n) _Pragma("unroll") for (int k = 0; k < 2; ++k) dst[n][k] = *(const PG8_LAS bf16x8*)(lds + PG8_SB(b, h) + boff + n * 2048 + k * 1024); } while (0)
#define PG8_MMA(ai, bj, At, Bt) do { __builtin_amdgcn_s_setprio(1); _Pragma("unroll") for (int m = 0; m < 4; ++m) _Pragma("unroll") for (int n = 0; n < 2; ++n) _Pragma("unroll") for (int k = 0; k < 2; ++k) \
        acc[ai][bj][m][n] = __builtin_amdgcn_mfma_f32_16x16x32_bf16(Bt[n][k], At[m][k], acc[ai][bj][m][n], 0, 0, 0); __builtin_amdgcn_s_setprio(0); } while (0)
#define PG8_WAIT_V(n) asm volatile("s_waitcnt vmcnt(" #n ")" ::: "memory")
#define PG8_WAIT_L(n) asm volatile("s_waitcnt lgkmcnt(" #n ")" ::: "memory")
#define PG8_BAR __builtin_amdgcn_s_barrier()
#define PG8_SCHED __builtin_amdgcn_sched_barrier(0)
    Unit cur, nxt; int ui = 0;
    if (!S.next(0, cur)) return;
    f32x4 acc[2][2][4][2];
#pragma unroll
    for (int a = 0; a < 2; ++a)
#pragma unroll
        for (int b = 0; b < 2; ++b)
#pragma unroll
            for (int m = 0; m < 4; ++m)
#pragma unroll
                for (int n = 0; n < 2; ++n) acc[a][b][m][n] = (f32x4){0.f, 0.f, 0.f, 0.f};
    bf16x8 At[4][2], B0[2][2], B1[2][2];
    const char* cA = (const char*)g.A + (size_t)cur.pm * tstep; const char* cB = (const char*)g.Bt + (size_t)cur.pn * tstep;
    S.a_ready(cur);
    E.prefetch(cur, wid, lane, 0);
    if constexpr (SP2) {
        PG8_STAGE(PG8_SB(0, 0), cB, voffB); PG8_STAGE(PG8_SB(0, 1), cB + hstep, voffB); PG8_STAGE(PG8_SA(0, 0), cA, voffA); PG8_STAGE(PG8_SA(0, 1), cA + hstep, voffA);
        if (wr == 1) PG8_BAR;
        PG8_WAIT_V(2); PG8_BAR;
        PG8_STAGE(PG8_SB(1, 0), cB + kstep, voffB); PG8_STAGE(PG8_SA(1, 0), cA + kstep, voffA); PG8_STAGE(PG8_SB(1, 1), cB + hstep + kstep, voffB);
        PG8_WAIT_V(6); PG8_BAR;
    } else {
        PG8_STAGE(PG8_SB(0, 0), cB, voffB); PG8_STAGE(PG8_SA(0, 0), cA, voffA); PG8_STAGE(PG8_SB(0, 1), cB + hstep, voffB); PG8_STAGE(PG8_SA(0, 1), cA + hstep, voffA);
        if (wr == 1) PG8_BAR;
        PG8_WAIT_V(4); PG8_BAR;
        PG8_STAGE(PG8_SB(1, 0), cB + kstep, voffB); PG8_STAGE(PG8_SA(1, 0), cA + kstep, voffA); PG8_STAGE(PG8_SB(1, 1), cB + hstep + kstep, voffB);
        PG8_WAIT_V(6); PG8_BAR;
    }
    for (;;) {
        const bool has_next = S.next(ui + 1, nxt);
        const char* nA = has_next ? (const char*)g.A + (size_t)nxt.pm * tstep : cA; const char* nB = has_next ? (const char*)g.Bt + (size_t)nxt.pn * tstep : cB;
        for (int t = 0; t < nt; t += 2) {
            const bool last = (t == nt - 2);
            const char* a1 = cA + (size_t)(t + 1) * kstep;
            const char* a2 = last ? nA : cA + (size_t)(t + 2) * kstep; const char* b2 = last ? nB : cB + (size_t)(t + 2) * kstep;
            const char* a3 = a2 + kstep; const char* b3 = b2 + kstep;
            if (last && has_next) S.a_ready(nxt);
            if constexpr (SP2) {
            PG8_LDB(B0, 0, 0); PG8_LDB(B1, 0, 1); PG8_SCHED; PG8_LDA(At, 0, 0); PG8_STAGE(PG8_SA(1, 1), a1 + hstep, voffA);
            PG8_WAIT_V(8); PG8_WAIT_L(0); PG8_BAR; PG8_MMA(0, 0, At, B0); PG8_MMA(0, 1, At, B1); PG8_BAR; PG8_SCHED;
            PG8_LDA(At, 0, 1); PG8_STAGE(PG8_SB(0, 0), b2, voffB); PG8_STAGE(PG8_SB(0, 1), b2 + hstep, voffB); PG8_STAGE(PG8_SA(0, 0), a2, voffA);
            PG8_WAIT_V(8); PG8_WAIT_L(0); PG8_BAR; PG8_MMA(1, 0, At, B0); PG8_MMA(1, 1, At, B1); PG8_BAR; PG8_SCHED;
            PG8_LDB(B0, 1, 0); PG8_LDB(B1, 1, 1); PG8_SCHED; PG8_LDA(At, 1, 0); PG8_STAGE(PG8_SA(0, 1), a2 + hstep, voffA);
            PG8_WAIT_V(8); PG8_WAIT_L(0); PG8_BAR; PG8_MMA(0, 0, At, B0); PG8_MMA(0, 1, At, B1); PG8_BAR; PG8_SCHED;
            PG8_LDA(At, 1, 1); PG8_STAGE(PG8_SB(1, 0), b3, voffB); PG8_STAGE(PG8_SB(1, 1), b3 + hstep, voffB); PG8_STAGE(PG8_SA(1, 0), a3, voffA);
            PG8_WAIT_V(8); PG8_WAIT_L(0); PG8_BAR; PG8_MMA(1, 0, At, B0); PG8_MMA(1, 1, At, B1); PG8_BAR; PG8_SCHED;
            } else {
            PG8_LDB(B0, 0, 0); PG8_SCHED; PG8_LDA(At, 0, 0); PG8_STAGE(PG8_SA(1, 1), a1 + hstep, voffA);
            PG8_WAIT_L(8); PG8_BAR; PG8_WAIT_L(0); PG8_MMA(0, 0, At, B0); PG8_BAR; PG8_SCHED;
            PG8_LDB(B1, 0, 1); PG8_STAGE(PG8_SB(0, 0), b2, voffB);
            PG8_BAR; PG8_WAIT_L(0); PG8_MMA(0, 1, At, B1); PG8_BAR;
            PG8_LDA(At, 0, 1); PG8_STAGE(PG8_SA(0, 0), a2, voffA);
            PG8_BAR; PG8_WAIT_L(0); PG8_MMA(1, 0, At, B0); PG8_BAR; PG8_SCHED;
            PG8_STAGE(PG8_SB(0, 1), b2 + hstep, voffB);
            PG8_WAIT_V(6); PG8_BAR; PG8_MMA(1, 1, At, B1); PG8_BAR;
            PG8_LDB(B0, 1, 0); PG8_SCHED; PG8_LDA(At, 1, 0); PG8_STAGE(PG8_SA(0, 1), a2 + hstep, voffA);
            PG8_WAIT_L(8); PG8_BAR; PG8_WAIT_L(0); PG8_MMA(0, 0, At, B0); PG8_BAR; PG8_SCHED;
            PG8_LDB(B1, 1, 1); PG8_STAGE(PG8_SB(1, 0), b3, voffB);
            PG8_BAR; PG8_WAIT_L(0); PG8_MMA(0, 1, At, B1); PG8_BAR;
            PG8_LDA(At, 1, 1); PG8_STAGE(PG8_SA(1, 0), a3, voffA);
            PG8_BAR; PG8_WAIT_L(0); PG8_MMA(1, 0, At, B0); PG8_BAR; PG8_SCHED;
            PG8_STAGE(PG8_SB(1, 1), b3 + hstep, voffB);
            PG8_WAIT_V(6); PG8_BAR; PG8_MMA(1, 1, At, B1); PG8_BAR;
            }
        }
        if constexpr (ALIGN_EPI) { if (wr == 0) PG8_BAR; }
        if constexpr (!Epi::AFTER_DRAIN) { E(acc, cur, wr, wc, fr, fq, ui & 1); S.done(cur); }
        if (!has_next) break;
#pragma unroll
        for (int a = 0; a < 2; ++a)
#pragma unroll
            for (int b = 0; b < 2; ++b)
#pragma unroll
                for (int m = 0; m < 4; ++m)
#pragma unroll
                    for (int n = 0; n < 2; ++n) acc[a][b][m][n] = (f32x4){0.f, 0.f, 0.f, 0.f};
        cur = nxt; cA = nA; cB = nB; ++ui;
        E.prefetch(cur, wid, lane, ui & 1);
        if constexpr (ALIGN_EPI) { if (wr == 1) PG8_BAR; }
    }
    PG8_WAIT_V(0);
    if constexpr (!ALIGN_EPI) { if (wr == 0) PG8_BAR; }
    PG8_BAR;
    if constexpr (Epi::AFTER_DRAIN) { E.fused(acc, cur, wr, wc, fr, fq, lds, wid, lane); S.done(cur); }
#undef PG8_SA
#undef PG8_SB
#undef PG8_STAGE
#undef PG8_LDA
#undef PG8_LDB
#undef PG8_MMA
#undef PG8_WAIT_V
#undef PG8_WAIT_L
#undef PG8_BAR
#undef PG8_SCHED
}
}

#define LAS __attribute__((address_space(3)))
typedef LAS unsigned char* ldsp;
typedef unsigned short bf16_t;
typedef short bf16x8 __attribute__((ext_vector_type(8)));
typedef short s16x4 __attribute__((ext_vector_type(4)));
typedef float f32x4 __attribute__((ext_vector_type(4)));
typedef float f32x16 __attribute__((ext_vector_type(16)));
typedef unsigned u32x4 __attribute__((ext_vector_type(4)));
typedef unsigned u32x2 __attribute__((ext_vector_type(2)));

struct Params {
    const float* x; const float* norm_gain; const float* w_in_ab; const float* b_forget;
    const float* moba_q_gain; const float* moba_k_gain; const float* fox_q_gain; const float* fox_k_gain; const float* w_out_ab;
    const float* w_in_cd; const float* diff_q_gain; const float* diff_k_gain; const float* diff_lambda; const float* diff_subln_gain;
    const float* swa_q_gain; const float* swa_k_gain; const float* swa_sinks; const float* w_out_cd;
    float* out; unsigned char* ws; int ph_lo, ph_hi;
};
typedef const __attribute__((address_space(4))) Params* CP;
constexpr size_t MiB = 1u << 20;
constexpr size_t WS_CTL = 0, CTL_ZERO_BYTES = 128 * 1024;
constexpr int CW_PANEL = 16384;
constexpr size_t WS_WT_AB = 2 * MiB, WS_WT_CD = 18 * MiB, WS_WT_OUT = 32 * MiB, WS_WF = 40 * MiB, WS_SSQ = 41 * MiB, WS_LOGF = 43 * MiB, WS_KMEAN = 44 * MiB;
constexpr size_t WS_XB = 48 * MiB, WS_Y = 112 * MiB, WS_PROJ = 176 * MiB, WS_END = 432 * MiB;
constexpr int LDS_RING = 131072, LDS_MISC = 131072, LDS_BYTES = 155648, LDS_QW = LDS_BYTES - 64;
constexpr int NPHASE = 13;
constexpr size_t HB = (size_t)MTOK * 64;

__device__ __forceinline__ float wave_sum(float v) {
    v = rsum16(v); v = xadd16(v); v = xadd32(v);
    return v;
}
__device__ __forceinline__ float wave_max(float v) {
    v = rmax16(v); v = xmax16(v); v = xmax32(v);
    return v;
}
__device__ __forceinline__ float bf2f(unsigned short b) { return __uint_as_float((unsigned)b << 16); }
__device__ __forceinline__ unsigned pk_bf16(float lo, float hi) { return pg8::cvt_pk_bf16(lo, hi); }

__device__ __forceinline__ void transpose_item(const float* W, int ldw, int k0, int nsrc0, const float* gain, bf16_t* WT, int ndst0, LAS float* scr, int lane) {
    float wv[32];
#pragma unroll
    for (int i = 0; i < 32; ++i) { const int kk = 2 * i + (lane >> 5); wv[i] = W[(size_t)(k0 + kk) * ldw + nsrc0 + (lane & 31)]; }
    const float g0 = gain ? gain[k0 + (lane & 63)] : 1.0f;
#pragma unroll
    for (int i = 0; i < 32; ++i) { const int kk = 2 * i + (lane >> 5); scr[kk * 33 + (lane & 31)] = wv[i] * __shfl(g0, kk); }
    asm volatile("s_waitcnt lgkmcnt(0)" ::: "memory");
    const int c = lane & 7;
#pragma unroll
    for (int j = 0; j < 4; ++j) { const int n = (lane >> 3) + 8 * j; const LAS float* s = scr + (8 * c) * 33 + n;
        u32x4 o; o.x = pk_bf16(s[0 * 33], s[1 * 33]); o.y = pk_bf16(s[2 * 33], s[3 * 33]); o.z = pk_bf16(s[4 * 33], s[5 * 33]); o.w = pk_bf16(s[6 * 33], s[7 * 33]);
        *(u32x4*)(WT + (size_t)(ndst0 + n) * 1024 + k0 + 8 * c) = o; }
    asm volatile("s_waitcnt lgkmcnt(0)" ::: "memory");
}
__device__ __forceinline__ int logical_group(int nbp) { const int pn = nbp >> 3, bj = (nbp >> 2) & 1, wc = nbp & 3; return pn * 8 + wc * 2 + bj; }

constexpr int I_AB = 16 * 128, I_CD = 16 * 104, I_OUT = 16 * 32, NIT = 2 * I_AB + 2 * I_CD + 4 * I_OUT, CONV_DEFER = NIT - I_AB, CONV_TICKETS = CONV_DEFER / 32;
static_assert(CONV_DEFER % 32 == 0, "conversion tickets");
__device__ __forceinline__ void convert_item(CP P, int it, LAS float* scr, int lane) {
        int r = it;
        if (r < 2 * I_AB) { const int l = r / I_AB; r -= l * I_AB; const int kb = r / 128, nbp = r % 128;
            transpose_item(P->w_in_ab + (size_t)l * 1024 * AB_SRC, AB_SRC, kb * 64, logical_group(nbp) * 32, P->norm_gain + (2 * l) * 1024, (bf16_t*)(P->ws + WS_WT_AB) + (size_t)l * AB_N * 1024, nbp * 32, scr, lane); return; }
        r -= 2 * I_AB;
        if (r < 2 * I_CD) { const int l = r / I_CD; r -= l * I_CD; const int kb = r / 104, nbp = r % 104;
            transpose_item(P->w_in_cd + (size_t)l * 1024 * CD_N, CD_N, kb * 64, logical_group(nbp) * 32, P->norm_gain + (2 * l + 1) * 1024, (bf16_t*)(P->ws + WS_WT_CD) + (size_t)l * CD_N * 1024, nbp * 32, scr, lane); return; }
        r -= 2 * I_CD;
        { const int L = r / I_OUT; r -= L * I_OUT; const int kb = r / 32, nb = r % 32;
            const float* W = (L & 1) ? P->w_out_cd + (size_t)(L >> 1) * 1024 * 1024 : P->w_out_ab + (size_t)(L >> 1) * 1024 * 1024;
            transpose_item(W, 1024, kb * 64, nb * 32, nullptr, (bf16_t*)(P->ws + WS_WT_OUT) + (size_t)L * 1024 * 1024, nb * 32, scr, lane); }
}
__device__ __forceinline__ void phase_prologue(CP P, ldsp lds) {
    const int tid = opaque_tid(), lane = tid & 63, wid = tid >> 6;
    const int gw = blockIdx.x * 8 + wid, NGW = gridDim.x * 8;
    LAS float* scr = (LAS float*)(lds + wid * 16384);
    for (int it = gw; it < I_AB; it += NGW) convert_item(P, it, scr, lane);
    { bf16_t* WF = (bf16_t*)(P->ws + WS_WF);
      for (int i = blockIdx.x * 512 + tid; i < 2 * 16 * 1024; i += gridDim.x * 512) { const int l = i >> 14, j = (i >> 10) & 15, k = i & 1023;
          const float w = (j < 8) ? P->w_in_ab[((size_t)l * 1024 + k) * AB_SRC + 4096 + j] * P->norm_gain[(2 * l) * 1024 + k] : 0.f;
          const unsigned h = pk_bf16(w, 0.f) & 0xffffu; const float wl = w - __uint_as_float(h << 16);
          WF[(size_t)(l * 2 + 0) * 16384 + j * 1024 + k] = (bf16_t)h; WF[(size_t)(l * 2 + 1) * 16384 + j * 1024 + k] = (bf16_t)(pk_bf16(wl, 0.f) & 0xffffu); } }
    { bf16_t* XB = (bf16_t*)(P->ws + WS_XB); float* SSQ = (float*)(P->ws + WS_SSQ);
      for (int m0 = gw; m0 < MTOK; m0 += 4 * NGW) {
          f32x4 v[4][4];
#pragma unroll
          for (int q = 0; q < 4; ++q) { const int mq = (m0 + q * NGW < MTOK) ? m0 + q * NGW : m0; const f32x4* xr = (const f32x4*)(P->x + (size_t)mq * DM) + lane;
#pragma unroll
              for (int j = 0; j < 4; ++j) v[q][j] = xr[64 * j]; }
#pragma unroll
          for (int q = 0; q < 4; ++q) { const int m = m0 + q * NGW; if (m >= MTOK) break; float s = 0.f;
#pragma unroll
              for (int j = 0; j < 4; ++j) s += (v[q][j][0] * v[q][j][0] + v[q][j][1] * v[q][j][1]) + (v[q][j][2] * v[q][j][2] + v[q][j][3] * v[q][j][3]);
              s = wave_sum(s);
              if (lane == 0) *(f32x4*)(SSQ + (size_t)m * 4) = (f32x4){s, 0.f, 0.f, 0.f};
              u32x2* o8 = (u32x2*)(XB + (size_t)m * DM) + lane;
#pragma unroll
              for (int j = 0; j < 4; ++j) { u32x2 w; w.x = pk_bf16(v[q][j][0], v[q][j][1]); w.y = pk_bf16(v[q][j][2], v[q][j][3]); o8[64 * j] = w; } }
      } }
}

__device__ __forceinline__ void fgate_pass(CP P, int lj, ldsp lds) {
    typedef float f32x4v __attribute__((ext_vector_type(4)));
    const int tid = opaque_tid(), lane = tid & 63, wid = tid >> 6;
    const int gw = blockIdx.x * 8 + wid, NGW = gridDim.x * 8;
    const bf16_t* XB = (const bf16_t*)(P->ws + WS_XB); const float* SSQ = (const float*)(P->ws + WS_SSQ); float* LOGF = (float*)(P->ws + WS_LOGF);
    const int fr = lane & 15, fq = lane >> 4;
    const float bfj = (fr < 8) ? P->b_forget[lj * 8 + fr] : 0.f;
    constexpr int WROW = 2064;
    __syncthreads();
    { const u32x4* src = (const u32x4*)((const bf16_t*)(P->ws + WS_WF) + (size_t)lj * 2 * 16384);
#pragma unroll
      for (int j = 0; j < 8; ++j) { const int i = tid + 512 * j, row = i >> 7, ch = i & 127; *(LAS u32x4*)(lds + row * WROW + ch * 16) = src[i]; } }
    __syncthreads();
    for (int rg = gw; rg < MTOK / 16; rg += NGW) {
        const bf16_t* xa = XB + (size_t)(rg * 16 + fr) * DM + fq * 8;
        bf16x8 av[32];
#pragma unroll
        for (int ks = 0; ks < 32; ++ks) av[ks] = *(const bf16x8*)(xa + ks * 32);
        f32x4 s4[4];
#pragma unroll
        for (int j = 0; j < 4; ++j) s4[j] = *(const f32x4*)(SSQ + (size_t)(rg * 16 + 4 * fq + j) * 4);
        const unsigned wb = (unsigned)(uintptr_t)lds + fr * WROW + fq * 16;
        f32x4v acc = (f32x4v){0.f, 0.f, 0.f, 0.f};
#pragma unroll
        for (int c = 0; c < 8; ++c) {
            bf16x8 bh[4], bl[4];
#pragma unroll
            for (int i = 0; i < 4; ++i) { const int ks = 4 * c + i; bh[i] = *(const LAS bf16x8*)(wb + ks * 64); bl[i] = *(const LAS bf16x8*)(wb + 16 * WROW + ks * 64); }
#pragma unroll
            for (int i = 0; i < 4; ++i) { const int ks = 4 * c + i; acc = __builtin_amdgcn_mfma_f32_16x16x32_bf16(av[ks], bh[i], acc, 0, 0, 0); acc = __builtin_amdgcn_mfma_f32_16x16x32_bf16(av[ks], bl[i], acc, 0, 0, 0); }
            __builtin_amdgcn_sched_barrier(0);
        }
        if (fr < 8) {
#pragma unroll
            for (int j = 0; j < 4; ++j) { const int row = rg * 16 + 4 * fq + j;
                const float rs = 1.0f / sqrtf(((s4[j][0] + s4[j][1]) + (s4[j][2] + s4[j][3])) * (1.0f / 1024.0f) + EPS);
                const float z = acc[j] * rs + bfj; const float lf = fminf(z, 0.f) - log1pf(expf(-fabsf(z)));
                LOGF[((size_t)(row >> 11) * 8 + fr) * SEQ + (row & 2047)] = lf; }
        }
    }
}

__device__ __forceinline__ void glds16(const void* gsrc, unsigned lds_dst) { unsigned keep;
    asm volatile("s_mov_b32 %0, m0\n\ts_mov_b32 m0, %2\n\ts_nop 0\n\tglobal_load_lds_dwordx4 %1, off\n\ts_mov_b32 m0, %0" : "=&s"(keep) : "v"(gsrc), "s"(lds_dst) : "memory"); }
__device__ __forceinline__ float fadd_s(float a, float b) { asm("" : "+v"(b)); return a + b; }
__device__ __forceinline__ int crow(int r, int hi) { return (r & 3) + 8 * (r >> 2) + 4 * hi; }
__device__ __forceinline__ s16x4 vtr(unsigned addr) { typedef short v4i16_t __attribute__((ext_vector_type(4))); return __builtin_bit_cast(s16x4, __builtin_amdgcn_ds_read_tr16_b64_v4i16((LAS v4i16_t*)addr)); }

template <int VAR>
__device__ __forceinline__ void attn_unit(CP P, int lj, int ub, int uh, int uq, ldsp lds) {
    constexpr int DV = (VAR == 2) ? 128 : 64, NDB = DV / 32, NP = (VAR == 2) ? 2 : 1;
#define HM(row, col) ((size_t)((col) >> 6) * HB + (size_t)(row) * 64 + ((col) & 63))
    constexpr int KTB = (VAR == 2) ? 16384 : 8192, VTB = KTB;
    constexpr bool PIPE = (VAR < 2);
    constexpr int GP = DV * 2, GSB = 32 * GP;
    constexpr int DPF = PIPE ? 4 : 2, NS = PIPE ? DPF + 2 : DPF + 1, SLOT = KTB + VTB;
    constexpr int RINGB = (NS * SLOT < 65536) ? 65536 : NS * SLOT;
    constexpr int L_AUX = RINGB, L_WS = L_AUX + 8192, L_G = L_WS + 2048;
    static_assert(L_G + ((VAR == 2) ? 4 : 8) * GSB <= LDS_QW, "attention LDS map");
    const int tid = opaque_tid(), lane = tid & 63, wid = __builtin_amdgcn_readfirstlane(tid >> 6), r32 = lane & 31, hi = lane >> 5;
    const bf16_t* proj = (const bf16_t*)(P->ws + WS_PROJ);
    bf16_t* Y = (bf16_t*)(P->ws + WS_Y);
    const size_t rowb = (size_t)ub * SEQ;
    int colQ, colK, colV, colG, colY, wq0, t_lo, t_hi; float slope2 = 0.f; const float *gqp, *gkp;
    if constexpr (VAR == 0) { colQ = uh * 64; colK = 512 + uh * 64; colV = 1024 + uh * 64; colG = 1536 + uh * 64; colY = uh * 64; wq0 = uq * 256 + wid * 32; t_lo = 0; t_hi = 4 * uq + 4;
        slope2 = exp2f(-(float)(uh + 1)) * LOG2E; gqp = P->moba_q_gain + lj * 64; gkp = P->moba_k_gain + lj * 64; }
    else if constexpr (VAR == 1) { colQ = 2048 + uh * 64; colK = 2560 + uh * 64; colV = 3072 + uh * 64; colG = 3584 + uh * 64; colY = 512 + uh * 64; wq0 = uq * 256 + wid * 32; t_lo = 0; t_hi = 4 * uq + 4;
        gqp = P->fox_q_gain + lj * 64; gkp = P->fox_k_gain + lj * 64; }
    else if constexpr (VAR == 2) { const int c = wid >> 2; colQ = uh * 128 + c * 64; colK = 512 + uh * 128; colV = 1024 + uh * 128; colG = 1536 + uh * 128; colY = uh * 128; wq0 = uq * 128 + (wid & 3) * 32; t_lo = 0; t_hi = 2 * uq + 2;
        slope2 = exp2f(-2.0f * (float)(uh + 1)) * LOG2E; gqp = P->diff_q_gain + lj * 64; gkp = P->diff_k_gain + lj * 64; }
    else { const int hq = 4 * uh + (wid & 3); colQ = 2048 + hq * 64; colK = 2560 + uh * 64; colV = 2688 + uh * 64; colG = 2816 + hq * 64; colY = 512 + hq * 64; wq0 = uq * 64 + (wid >> 2) * 32; t_lo = uq >= 2 ? uq - 2 : 0; t_hi = uq + 1;
        slope2 = exp2f(-(float)(hq + 1)) * LOG2E; gqp = P->swa_q_gain + lj * 64; gkp = P->swa_k_gain + lj * 64; }
    const int t = wq0 + r32;
    const int twmin = wq0, twmax = wq0 + 31;
    const unsigned lds0 = (unsigned)(uintptr_t)lds;
    const int krow = 8 * wid + (lane >> 3);
    const bf16_t* kgd = proj + HM(rowb + krow, colK) + (((lane & 7) ^ ((krow >> 1) & 7)) * 8);
    const bf16_t* vgd = proj + HM(rowb + 16 * (wid & 3) + (lane >> 2), colV) + (wid >> 2) * 32 + (lane & 3) * 8;
    const int n_hi = t_hi - 1;
#define DMA_TILE(j, slot) do { int tj_ = n_hi - (j); tj_ = tj_ < t_lo ? t_lo : tj_; const size_t ro_ = (size_t)tj_ * 64 * 64; const unsigned sl_ = (unsigned)(slot) * SLOT + wid * 1024; \
        _Pragma("unroll") for (int p_ = 0; p_ < NP; ++p_) glds16(kgd + ro_ + p_ * HB, (unsigned)__builtin_amdgcn_readfirstlane((int)(lds0 + sl_ + p_ * 8192))); \
        _Pragma("unroll") for (int p_ = 0; p_ < NP; ++p_) glds16(vgd + ro_ + p_ * HB, (unsigned)__builtin_amdgcn_readfirstlane((int)(lds0 + sl_ + KTB + p_ * 8192))); } while (0)
#pragma unroll
    for (int j = 0; j < 2; ++j) DMA_TILE(j, j);
    bf16x8 qr[4];
    { const bf16_t* qrow = proj + HM(rowb + t, colQ);
#pragma unroll
      for (int d0 = 0; d0 < 4; ++d0) qr[d0] = *(const bf16x8*)(qrow + d0 * 16 + hi * 8); }
    const unsigned gbase = lds0 + L_G + ((VAR == 2) ? (wid & 3) : wid) * GSB;
    float gqv, gkv;
    float sinkv = 0.f; if constexpr (VAR == 3) sinkv = P->swa_sinks[lj * 8 + 4 * uh + (wid & 3)];
    f32x4 lfv = (f32x4){0.f, 0.f, 0.f, 0.f}; float km0 = 0.f, km1 = 0.f;
    if constexpr (VAR == 1) lfv = *(const f32x4*)((const float*)(P->ws + WS_LOGF) + ((size_t)ub * 8 + uh) * SEQ + 4 * tid);
    if constexpr (VAR == 0) { const float* kp = (const float*)(P->ws + WS_KMEAN); const int n = tid >> 6, d = tid & 63;
        km0 = kp[((size_t)((ub * 8 + n) * 2 + 0) * 8 + uh) * 64 + d]; km1 = kp[((size_t)((ub * 8 + n) * 2 + 1) * 8 + uh) * 64 + d]; }
    { const float gq_ = gqp[lane], gk_ = gkp[lane];
      __builtin_amdgcn_sched_barrier(0);
      gqv = gq_; gkv = gk_; }
    const float M0 = 8.0f * wave_max(fabsf(gqv)) * wave_max(fabsf(gkv)) * LOG2E;
    unsigned sel = 0u; float cst = 0.f;
    if constexpr (VAR == 0) {
        if (uq >= 4) {
            LAS float* km = (LAS float*)(lds + L_AUX);
            if (tid < uq * 64) km[tid] = (km0 + km1) * (1.0f / 256.0f);
            __syncthreads();
            float g[7];
#pragma unroll
            for (int n = 0; n < 7; ++n) { float a = 0.f;
                if (n < uq) {
#pragma unroll
                    for (int d0 = 0; d0 < 4; ++d0) { const f32x4 k0 = *(const LAS f32x4*)(km + n * 64 + d0 * 16 + hi * 8), k1 = *(const LAS f32x4*)(km + n * 64 + d0 * 16 + hi * 8 + 4);
#pragma unroll
                        for (int e = 0; e < 4; ++e) { a += bf2f((unsigned short)qr[d0][e]) * k0[e]; a += bf2f((unsigned short)qr[d0][4 + e]) * k1[e]; } }
                }
                a = xadd32(a); g[n] = a; }
#pragma unroll
            for (int pick = 0; pick < 3; ++pick) { float best = -INFINITY; int bi = -1;
#pragma unroll
                for (int n = 0; n < 7; ++n) { const bool ok = (n < uq) && !((sel >> n) & 1u) && (g[n] > best); best = ok ? g[n] : best; bi = ok ? n : bi; }
                if (bi >= 0) sel |= 1u << bi; }
        } else sel = (1u << uq) - 1u;
        sel |= 1u << uq;
    }
    if constexpr (VAR == 1) {
        LAS float* cs = (LAS float*)(lds + L_AUX); LAS float* wt = (LAS float*)(lds + L_WS);
        f32x4 v = lfv;
        v[1] += v[0]; v[2] += v[1]; v[3] += v[2];
        float incl = v[3];
#pragma unroll
        for (int o = 1; o < 64; o <<= 1) { const float u = __shfl_up(incl, o); if (lane >= o) incl += u; }
        if (lane == 63) wt[wid] = incl;
        __syncthreads();
        float woff = 0.f;
#pragma unroll
        for (int w = 0; w < 8; ++w) woff += (w < wid) ? wt[w] : 0.f;
        const float ex = incl - v[3] + woff;
        *(LAS f32x4*)(cs + 4 * tid) = (f32x4){(ex + v[0]) * LOG2E, (ex + v[1]) * LOG2E, (ex + v[2]) * LOG2E, (ex + v[3]) * LOG2E};
        __syncthreads();
        cst = cs[t] - M0;
    }
    const float TH = 2.0f * M0 + 27.0f;
    float THw = TH;
    bool have_m = false;
    int t_first = t_lo; float dmax = 1e30f; float cs_wmin = 0.f;
    if constexpr (VAR == 0 || VAR == 2) {
        dmax = TH / slope2;
        const int t_umin = (VAR == 0) ? uq * 256 : uq * 128;
        const float f = ((float)t_umin - dmax - 63.0f) * (1.0f / 64.0f);
        if (f > (float)t_lo) { const int c = (int)ceilf(f); t_first = c < t_hi - 1 ? c : t_hi - 1; }
    }
    if constexpr (VAR == 1) {
        const LAS float* cs = (const LAS float*)(lds + L_AUX);
        const float cu = cs[uq * 256];
        { const int ti_ = lane & 31; const bool keep_ = (ti_ >= t_hi - 1) || ((cu - cs[ti_ * 64 + 63]) >= -TH);
          t_first = __builtin_amdgcn_readfirstlane(__builtin_ctzll(__ballot(keep_) | (1ull << 31))); }
        cs_wmin = cs[twmin];
    }
    int tw_first = 0;
#define FOX_FIRST() do { if constexpr (VAR == 1) { const int ti_ = lane & 31; const bool keep_ = (ti_ * 64 + 63 >= twmin) || ((cs_wmin - ((const LAS float*)(lds + L_AUX))[ti_ * 64 + 63]) >= -THw); \
        const unsigned long long bm_ = __ballot(keep_); tw_first = __builtin_amdgcn_readfirstlane(__builtin_ctzll(bm_ | (1ull << 31))); } } while (0)
    FOX_FIRST();
    const int n = t_hi - t_first;
    unsigned kro[4];
#pragma unroll
    for (int d0 = 0; d0 < 4; ++d0) { const int ch = 2 * d0 + hi; kro[d0] = lds0 + ((VAR == 2) ? (wid >> 2) * 8192 : 0) + r32 * 128 + ((ch ^ ((r32 >> 1) & 7)) << 4); }
    const unsigned vro = lds0 + KTB + ((lane >> 4) & 1) * 32 + (lane & 3) * 8 + (4 * hi + ((lane & 15) >> 2)) * 64;
    f32x16 o[NDB];
#pragma unroll
    for (int db = 0; db < NDB; ++db) o[db] = (f32x16){};
    float lsum = 0.f;
#define ACT(tt, out) do { const int kv0_ = (tt) * 64; bool a_ = kv0_ <= twmax; \
        if constexpr (VAR == 0 || VAR == 2) a_ = a_ && ((float)(twmin - (kv0_ + 63)) * slope2 <= THw); \
        if constexpr (VAR == 1) a_ = a_ && ((tt) >= tw_first); \
        out = a_; } while (0)
#define QK_STEP(tt, kb, P0, P1) do { const int kv0_ = (tt) * 64; bf16x8 kf[8]; \
        _Pragma("unroll") for (int d0 = 0; d0 < 4; ++d0) { kf[2 * d0] = *(const LAS bf16x8*)(kro[d0] + (kb) * SLOT); kf[2 * d0 + 1] = *(const LAS bf16x8*)(kro[d0] + (kb) * SLOT + 4096); } \
        if constexpr (VAR == 1) { const LAS float* cs_ = (const LAS float*)(lds + L_AUX) + kv0_ + 4 * hi; f32x4 c0[4], c1[4]; \
            _Pragma("unroll") for (int g4 = 0; g4 < 4; ++g4) { c0[g4] = *(const LAS f32x4*)(cs_ + 8 * g4); c1[g4] = *(const LAS f32x4*)(cs_ + 32 + 8 * g4); } \
            __builtin_amdgcn_sched_barrier(0);        \
            _Pragma("unroll") for (int g4 = 0; g4 < 4; ++g4) { _Pragma("unroll") for (int e = 0; e < 4; ++e) { P0[4 * g4 + e] = cst - c0[g4][e]; P1[4 * g4 + e] = cst - c1[g4][e]; } } \
        } else { __builtin_amdgcn_sched_barrier(0); float base = slope2 * (float)(kv0_ + 4 * hi - t) - M0; \
            if constexpr (VAR == 0) { if (!((sel >> ((tt) >> 2)) & 1u)) base = -1e30f; } \
            _Pragma("unroll") for (int r = 0; r < 16; ++r) { P0[r] = fmaf(slope2, (float)(8 * (r >> 2) + (r & 3)), base); P1[r] = fmaf(slope2, (float)(32 + 8 * (r >> 2) + (r & 3)), base); } } \
        _Pragma("unroll") for (int d0 = 0; d0 < 4; ++d0) { P0 = __builtin_amdgcn_mfma_f32_32x32x16_bf16(kf[2 * d0], qr[d0], P0, 0, 0, 0); P1 = __builtin_amdgcn_mfma_f32_32x32x16_bf16(kf[2 * d0 + 1], qr[d0], P1, 0, 0, 0); } \
    } while (0)
#define SM_STEP(tt, vb, P0, P1) do { const int kv0_ = (tt) * 64; \
        if (kv0_ + 63 > twmin) { _Pragma("unroll") for (int r = 0; r < 16; ++r) { const int kv = kv0_ + crow(r, hi); if (kv > t) P0[r] = -INFINITY; if (kv + 32 > t) P1[r] = -INFINITY; } } \
        if constexpr (VAR == 3) { if (kv0_ <= twmax - 128) { _Pragma("unroll") for (int r = 0; r < 16; ++r) { const int kv = kv0_ + crow(r, hi); if (kv <= t - 128) P0[r] = -INFINITY; if (kv + 32 <= t - 128) P1[r] = -INFINITY; } } } \
        if constexpr (VAR != 3) { if (!have_m) { float m_ = fmaxf(P0[0], P1[0]); _Pragma("unroll") for (int r = 1; r < 16; ++r) m_ = fmaxf(m_, fmaxf(P0[r], P1[r])); \
            m_ = xmax32(m_); m_ = rmin16(m_); m_ = xmin16(m_); \
            if (m_ > -1e20f) { THw = fminf(THw, 27.0f - m_); have_m = true; FOX_FIRST(); } } } \
          \
        float lacc_ = 0.f; u32x4 pwc_, pwn_ = (u32x4){0u, 0u, 0u, 0u}; s16x4 vl[NDB], vh[NDB]; \
        _Pragma("unroll") for (int e_ = 0; e_ < 8; ++e_) { P0[e_] = __builtin_amdgcn_exp2f(P0[e_]); lacc_ += P0[e_]; } \
        pwc_ = (u32x4){pk_bf16(P0[0], P0[1]), pk_bf16(P0[2], P0[3]), pk_bf16(P0[4], P0[5]), pk_bf16(P0[6], P0[7])}; \
        _Pragma("unroll") for (int ks_ = 0; ks_ < 4; ++ks_) { \
            _Pragma("unroll") for (int db = 0; db < NDB; ++db) { vl[db] = vtr(vro + (vb) * SLOT + db * 4096 + ks_ * 1024); vh[db] = vtr(vro + (vb) * SLOT + db * 4096 + ks_ * 1024 + 512); } \
            _Pragma("unroll") for (int db = 0; db < NDB; ++db) { \
                const bf16x8 vf = (bf16x8){vl[db][0], vl[db][1], vl[db][2], vl[db][3], vh[db][0], vh[db][1], vh[db][2], vh[db][3]}; \
                o[db] = __builtin_amdgcn_mfma_f32_32x32x16_bf16(__builtin_bit_cast(bf16x8, pwc_), vf, o[db], 0, 0, 0); \
                if (ks_ < 3) { constexpr int EPG = 8 / NDB;   \
                    _Pragma("unroll") for (int j_ = 0; j_ < EPG; ++j_) { const int e_ = 8 * ((ks_ + 1) & 1) + db * EPG + j_; \
                        if (ks_ + 1 < 2) { P0[e_] = __builtin_amdgcn_exp2f(P0[e_]); lacc_ += P0[e_]; } else { P1[e_] = __builtin_amdgcn_exp2f(P1[e_]); lacc_ += P1[e_]; } } \
                    if (EPG == 2) { const int e_ = 8 * ((ks_ + 1) & 1) + db * 2; pwn_[db] = (ks_ + 1 < 2) ? pk_bf16(P0[e_], P0[e_ + 1]) : pk_bf16(P1[e_], P1[e_ + 1]); } \
                    else { const int e_ = 8 * ((ks_ + 1) & 1) + db * 4; pwn_[2 * db] = (ks_ + 1 < 2) ? pk_bf16(P0[e_], P0[e_ + 1]) : pk_bf16(P1[e_], P1[e_ + 1]); pwn_[2 * db + 1] = (ks_ + 1 < 2) ? pk_bf16(P0[e_ + 2], P0[e_ + 3]) : pk_bf16(P1[e_ + 2], P1[e_ + 3]); } \
                    asm volatile("" : "+v"(lacc_), "+v"(pwn_)); } \
                __builtin_amdgcn_sched_barrier(0); } \
            pwc_ = pwn_; } \
        lsum += lacc_; \
    } while (0)
#define WAITBAR(N) asm volatile("s_waitcnt vmcnt(" #N ") lgkmcnt(0)\n\ts_barrier" ::: "memory")
#define ITER(ii, PA0, PA1, PB0, PB1) do { const int it_ = (ii), tt_ = n_hi - it_, bcur_ = sc, bnxt_ = (sc + 1 == NS) ? 0 : sc + 1; bool a0_, a1_ = false; ACT(tt_, a0_); \
        DMA_TILE(it_ + DPF, (sc == 0) ? NS - 1 : sc - 1); sc = bnxt_; \
        (void)a1_; (void)bnxt_; if (a0_) { QK_STEP(tt_, bcur_, PA0, PA1); SM_STEP(tt_, bcur_, PA0, PA1); } \
        if constexpr (NP == 2) WAITBAR(4); else WAITBAR(2); } while (0)
#define SB() __builtin_amdgcn_sched_barrier(0)
#define KLOAD2(d0, sl) do { kf[2 * (d0)] = *(const LAS bf16x8*)(kro[d0] + (sl) * SLOT); kf[2 * (d0) + 1] = *(const LAS bf16x8*)(kro[d0] + (sl) * SLOT + 4096); } while (0)
#define CINIT(tt, C0, C1) do { const int kv0_ = (tt) * 64; \
        if constexpr (VAR == 1) { const LAS float* cs_ = (const LAS float*)(lds + L_AUX) + kv0_ + 4 * hi; f32x4 c0[4]; \
            _Pragma("unroll") for (int g4 = 0; g4 < 4; ++g4) c0[g4] = *(const LAS f32x4*)(cs_ + 8 * g4); \
            SB(); \
            _Pragma("unroll") for (int g4 = 0; g4 < 4; ++g4) { _Pragma("unroll") for (int e = 0; e < 4; ++e) C0[4 * g4 + e] = cst - c0[g4][e]; } \
            _Pragma("unroll") for (int g4 = 0; g4 < 4; ++g4) c0[g4] = *(const LAS f32x4*)(cs_ + 32 + 8 * g4); \
            SB(); \
            _Pragma("unroll") for (int g4 = 0; g4 < 4; ++g4) { _Pragma("unroll") for (int e = 0; e < 4; ++e) C1[4 * g4 + e] = cst - c0[g4][e]; } \
        } else { float base = slope2 * (float)(kv0_ + 4 * hi - t) - M0; \
            if constexpr (VAR == 0) { if (!((sel >> ((tt) >> 2)) & 1u)) base = -1e30f; } \
            _Pragma("unroll") for (int r = 0; r < 16; ++r) { C0[r] = fmaf(slope2, (float)(8 * (r >> 2) + (r & 3)), base); C1[r] = fmaf(slope2, (float)(32 + 8 * (r >> 2) + (r & 3)), base); } } } while (0)
#define MASKM(tt, C0, C1) do { const int kv0_ = (tt) * 64; \
        if (kv0_ + 63 > twmin) { _Pragma("unroll") for (int r = 0; r < 16; ++r) { const int kv = kv0_ + crow(r, hi); if (kv > t) C0[r] = -INFINITY; if (kv + 32 > t) C1[r] = -INFINITY; } } \
        if constexpr (VAR == 3) { if (kv0_ <= twmax - 128) { _Pragma("unroll") for (int r = 0; r < 16; ++r) { const int kv = kv0_ + crow(r, hi); if (kv <= t - 128) C0[r] = -INFINITY; if (kv + 32 <= t - 128) C1[r] = -INFINITY; } } } \
        if constexpr (VAR != 3) { if (!have_m) { float m_ = fmaxf(C0[0], C1[0]); _Pragma("unroll") for (int r = 1; r < 16; ++r) m_ = fmaxf(m_, fmaxf(C0[r], C1[r])); \
            m_ = xmax32(m_); m_ = rmin16(m_); m_ = xmin16(m_); \
            if (m_ > -1e20f) { THw = fminf(THw, 27.0f - m_); have_m = true; FOX_FIRST(); } } } } while (0)
#define VRD(i, sl) do { vl[(i) & 3] = vtr(vro + (sl) * SLOT + ((i) >> 2) * 4096 + ((i) & 3) * 1024); vh[(i) & 3] = vtr(vro + (sl) * SLOT + ((i) >> 2) * 4096 + ((i) & 3) * 1024 + 512); } while (0)
#define VFR(i) ((bf16x8){vl[(i) & 3][0], vl[(i) & 3][1], vl[(i) & 3][2], vl[(i) & 3][3], vh[(i) & 3][0], vh[(i) & 3][1], vh[(i) & 3][2], vh[(i) & 3][3]})
#define PEL(P0, P1, k, j) (((k) < 4) ? P0[4 * ((k) & 3) + (j)] : P1[4 * ((k) & 3) + (j)])
#define QKM(k, C0, C1) do { if (((k) & 1) == 0) C0 = __builtin_amdgcn_mfma_f32_32x32x16_bf16(kf[k], qr[(k) >> 1], C0, 0, 0, 0); else C1 = __builtin_amdgcn_mfma_f32_32x32x16_bf16(kf[k], qr[(k) >> 1], C1, 0, 0, 0); } while (0)
#define SUMCVT4(k, P0, P1) do { lacc += PEL(P0, P1, k, 0); lacc += PEL(P0, P1, k, 1); lacc += PEL(P0, P1, k, 2); lacc += PEL(P0, P1, k, 3); \
        pw[(k) >> 1][((k) & 1) * 2] = pk_bf16(PEL(P0, P1, k, 0), PEL(P0, P1, k, 1)); pw[(k) >> 1][((k) & 1) * 2 + 1] = pk_bf16(PEL(P0, P1, k, 2), PEL(P0, P1, k, 3)); } while (0)
#define EXP4(k, C0, C1) do { _Pragma("unroll") for (int j_ = 0; j_ < 4; ++j_) { if ((k) < 4) C0[4 * ((k) & 3) + j_] = __builtin_amdgcn_exp2f(C0[4 * ((k) & 3) + j_]); else C1[4 * ((k) & 3) + j_] = __builtin_amdgcn_exp2f(C1[4 * ((k) & 3) + j_]); } } while (0)
#define PVM(k) do { o[(k) >> 2] = __builtin_amdgcn_mfma_f32_32x32x16_bf16(__builtin_bit_cast(bf16x8, pw[(k) & 3]), VFR(k), o[(k) >> 2], 0, 0, 0); } while (0)
#define PINV(x) asm volatile("" : "+v"(x))
#define GAPA(k, C0, C1, P0, P1, slv) do { if ((k) >= 4) VRD((k) - 4, slv); QKM(k, C0, C1); SUMCVT4(k, P0, P1); PINV(lacc); PINV(pw[(k) >> 1]); SB(); } while (0)
#define GAPB(k, C0, C1, slk, slv, dok) do { if ((k) >= 2 && (k) <= 5) KLOAD2((k) - 2, slk); PVM(k); if ((k) < 4) VRD((k) + 4, slv); EXP4(k, C0, C1); if ((k) < 4) PINV(C0); else PINV(C1); SB(); } while (0)
#define STEP(tstep, C0, C1, Pp0, Pp1) do { const int ts_ = (tstep), tt_ = n_hi - ts_; const int slc_ = sc, slp_ = (sc == 0) ? NS - 1 : sc - 1, sln_ = (sc + 1 == NS) ? 0 : sc + 1; \
        DMA_TILE(ts_ + DPF, (slp_ == 0) ? NS - 1 : slp_ - 1); sc = sln_; \
        bool a_next = false; if (ts_ + 1 < n) ACT(tt_ - 1, a_next); \
        const bool a_c = (ts_ < n) && a_cur; \
        if (a_c && a_prev) { \
            float lacc = 0.f; s16x4 vl[4], vh[4]; \
            CINIT(tt_, C0, C1); SB(); \
            GAPA(0, C0, C1, Pp0, Pp1, slp_); GAPA(1, C0, C1, Pp0, Pp1, slp_); GAPA(2, C0, C1, Pp0, Pp1, slp_); GAPA(3, C0, C1, Pp0, Pp1, slp_); \
            GAPA(4, C0, C1, Pp0, Pp1, slp_); GAPA(5, C0, C1, Pp0, Pp1, slp_); GAPA(6, C0, C1, Pp0, Pp1, slp_); GAPA(7, C0, C1, Pp0, Pp1, slp_); \
            lsum += lacc; MASKM(tt_, C0, C1); SB(); \
            GAPB(0, C0, C1, sln_, slp_, a_next); GAPB(1, C0, C1, sln_, slp_, a_next); GAPB(2, C0, C1, sln_, slp_, a_next); GAPB(3, C0, C1, sln_, slp_, a_next); \
            GAPB(4, C0, C1, sln_, slp_, a_next); GAPB(5, C0, C1, sln_, slp_, a_next); GAPB(6, C0, C1, sln_, slp_, a_next); GAPB(7, C0, C1, sln_, slp_, a_next); \
        } else { \
            if (a_c) { CINIT(tt_, C0, C1); SB(); _Pragma("unroll") for (int k_ = 0; k_ < 8; k_ += 2) { C0 = __builtin_amdgcn_mfma_f32_32x32x16_bf16(kf[k_], qr[k_ >> 1], C0, 0, 0, 0); C1 = __builtin_amdgcn_mfma_f32_32x32x16_bf16(kf[k_ + 1], qr[k_ >> 1], C1, 0, 0, 0); } } \
            if (a_prev) { float lacc = 0.f; s16x4 vl[4], vh[4]; VRD(0, slp_); VRD(1, slp_); VRD(2, slp_); VRD(3, slp_); \
                SUMCVT4(0, Pp0, Pp1); SUMCVT4(1, Pp0, Pp1); SUMCVT4(2, Pp0, Pp1); SUMCVT4(3, Pp0, Pp1); SUMCVT4(4, Pp0, Pp1); SUMCVT4(5, Pp0, Pp1); SUMCVT4(6, Pp0, Pp1); SUMCVT4(7, Pp0, Pp1); lsum += lacc; \
                PVM(0); PVM(1); PVM(2); PVM(3); VRD(4, slp_); VRD(5, slp_); VRD(6, slp_); VRD(7, slp_); PVM(4); PVM(5); PVM(6); PVM(7); } \
            if (a_c) { MASKM(tt_, C0, C1); EXP4(0, C0, C1); EXP4(1, C0, C1); EXP4(2, C0, C1); EXP4(3, C0, C1); EXP4(4, C0, C1); EXP4(5, C0, C1); EXP4(6, C0, C1); EXP4(7, C0, C1); } \
            if (a_next) { KLOAD2(0, sln_); KLOAD2(1, sln_); KLOAD2(2, sln_); KLOAD2(3, sln_); } \
        } \
        a_prev = a_c; a_cur = a_next; \
        asm volatile("s_waitcnt vmcnt(5) lgkmcnt(0)\n\ts_barrier" ::: "memory"); } while (0)
    asm volatile("" : "+v"(qr[0]), "+v"(qr[1]), "+v"(qr[2]), "+v"(qr[3]));
    asm volatile("s_waitcnt vmcnt(0) lgkmcnt(0)\n\ts_barrier" ::: "memory");
    if constexpr (PIPE) { DMA_TILE(2, 2); DMA_TILE(3, 3); }
    if (VAR != 2 || !(wid >> 2)) { constexpr int CPR = DV / 8, NG = 32 * CPR / 64;
#pragma unroll
        for (int i = 0; i < NG; ++i) { const int idx = i * 64 + lane, row = idx / CPR, ch = idx % CPR;
            glds16(proj + HM(rowb + wq0 + row, colG + ch * 8), (unsigned)__builtin_amdgcn_readfirstlane((int)(gbase + i * 1024))); } }
    f32x16 pa0, pa1, pb0, pb1; int sc = 0;
    if constexpr (PIPE) {
        bf16x8 kf[8]; u32x4 pw[4]; bool a_prev = false, a_cur;
        ACT(n_hi, a_cur);
        if (a_cur) { KLOAD2(0, 0); KLOAD2(1, 0); KLOAD2(2, 0); KLOAD2(3, 0); }
        for (int ts = 0; ts <= n; ts += 2) {
            STEP(ts, pa0, pa1, pb0, pb1);
            if (ts + 1 <= n) STEP(ts + 1, pb0, pb1, pa0, pa1);
        }
    } else {
        for (int i = 0; i < n; ++i) ITER(i, pa0, pa1, pb0, pb1);
    }
    asm volatile("s_waitcnt vmcnt(0) lgkmcnt(0)\n\ts_barrier" ::: "memory");
#undef DMA_TILE
#undef WAITBAR
#undef FOX_FIRST
#undef ACT
#undef QK_STEP
#undef SM_STEP
#undef ITER
#undef STEP
#undef GAPA
#undef PINV
#undef GAPB
#undef PVM
#undef EXP4
#undef SUMCVT4
#undef QKM
#undef PEL
#undef VFR
#undef VRD
#undef MASKM
#undef CINIT
#undef KLOAD2
#undef SB
    lsum = xadd32(lsum);
    if constexpr (VAR == 3) lsum += exp2f(sinkv * LOG2E - M0);
    LAS float* wsf = (LAS float*)(lds + L_WS) + wid * 64;
    if (hi == 0) wsf[r32] = 1.0f / lsum;
    asm volatile("s_waitcnt lgkmcnt(0)" ::: "memory");
    float rli[16];
#pragma unroll
    for (int r = 0; r < 16; ++r) rli[r] = wsf[crow(r, hi)];
#define OUT_ROWS(ost, NCH) do { asm volatile("s_waitcnt lgkmcnt(0)" ::: "memory"); \
        _Pragma("unroll") for (int i_ = 0; i_ < 32 * (NCH) / 64; ++i_) { const int idx_ = i_ * 64 + lane, row_ = idx_ / (NCH), ch_ = idx_ % (NCH); \
            const f32x4 a_ = *(const LAS f32x4*)((ost) + row_ * DV + ch_ * 8), b_ = *(const LAS f32x4*)((ost) + row_ * DV + ch_ * 8 + 4); \
            const u32x4 g_ = *(const LAS u32x4*)(gbase + row_ * GP + ch_ * 16); u32x4 w_; \
            w_.x = pk_bf16(a_[0] * __uint_as_float(g_.x << 16), a_[1] * __uint_as_float(g_.x & 0xffff0000u)); w_.y = pk_bf16(a_[2] * __uint_as_float(g_.y << 16), a_[3] * __uint_as_float(g_.y & 0xffff0000u)); \
            w_.z = pk_bf16(b_[0] * __uint_as_float(g_.z << 16), b_[1] * __uint_as_float(g_.z & 0xffff0000u)); w_.w = pk_bf16(b_[2] * __uint_as_float(g_.w << 16), b_[3] * __uint_as_float(g_.w & 0xffff0000u)); \
            *(u32x4*)(Y + (rowb + wq0 + row_) * DM + colY + ch_ * 8) = w_; } } while (0)
    if constexpr (VAR != 2) {
        LAS float* ost = (LAS float*)lds + wid * 2048;
#pragma unroll
        for (int r = 0; r < 16; ++r)
#pragma unroll
            for (int db = 0; db < NDB; ++db) ost[crow(r, hi) * DV + db * 32 + r32] = o[db][r] * rli[r];
        OUT_ROWS(ost, 8);
        __syncthreads();
    } else {
        int ljo = lj; asm volatile("" : "+s"(ljo));
        const float* lp = P->diff_lambda + ljo * 256; const int layer = 2 * ljo + 1;
        const float lam_init = 0.8f - 0.6f * expf(-0.3f * (float)layer);
        const float lam = expf(wave_sum(lp[lane] * lp[64 + lane])) - expf(wave_sum(lp[128 + lane] * lp[192 + lane])) + lam_init;
        LAS float* ex = (LAS float*)lds + (wid & 3) * 4096;
        if (wid >> 2) {
#pragma unroll
            for (int db = 0; db < NDB; ++db)
#pragma unroll
                for (int r = 0; r < 16; ++r) ex[(db * 16 + r) * 64 + lane] = o[db][r] * rli[r];
        }
        __syncthreads();
        if (!(wid >> 2)) {
            float ss[16];
#pragma unroll
            for (int r = 0; r < 16; ++r) { float a = 0.f;
#pragma unroll
                for (int db = 0; db < NDB; ++db) { const float v = o[db][r] * rli[r] - lam * ex[(db * 16 + r) * 64 + lane]; o[db][r] = v; a += v * v; }
                a = rsum16(a); a = xadd16(a);
                ss[r] = __builtin_amdgcn_rsqf(a * (1.0f / 128.0f) + EPS) * (1.0f - lam_init); }
            float sg[NDB];
#pragma unroll
            for (int db = 0; db < NDB; ++db) sg[db] = P->diff_subln_gain[lj * 128 + db * 32 + r32];
            asm volatile("s_waitcnt lgkmcnt(0)" ::: "memory");
            LAS float* ost = ex;
#pragma unroll
            for (int r = 0; r < 16; ++r)
#pragma unroll
                for (int db = 0; db < NDB; ++db) ost[crow(r, hi) * DV + db * 32 + r32] = o[db][r] * ss[r] * sg[db];
            OUT_ROWS(ost, 16);
        }
        __syncthreads();
    }
#undef OUT_ROWS
}

__device__ __forceinline__ void phase_attn(CP P, int layer, ldsp lds, unsigned* ctr) {
    const int tid = opaque_tid(); const int lj = layer >> 1;
    volatile LAS unsigned* qw = (volatile LAS unsigned*)(lds + LDS_QW);
    const unsigned G = gridDim.x;
    unsigned nxt = blockIdx.x;
    if (tid == 0) qw[8] = 0u;
    for (;;) {
        if (tid == 0) *qw = nxt;
        __syncthreads();
        const unsigned u = *qw;
        __syncthreads();
        unsigned ua = u;
        if (layer == 0) {
            if (u >= 2048u + CONV_TICKETS) break;
            if (u < 9u * CONV_TICKETS) { if (u % 9u == 8u) ua = 0xffffffffu; else ua = u - (u + 1u) / 9u; } else ua = u - CONV_TICKETS;
        } else if (u >= 2048u) break;
        const bool pre = true;
        if (pre && tid == 0) nxt = atomicAdd(ctr, 1u) + G;
        if (ua == 0xffffffffu) {
            const int tc = opaque_tid(), lane = tc & 63, wid = __builtin_amdgcn_readfirstlane(tc >> 6); LAS float* scr = (LAS float*)(lds + wid * 16384);
            CP Pc = P; asm volatile("" : "+s"(Pc));
            const int it0 = I_AB + __builtin_amdgcn_readfirstlane((int)(u / 9u)) * 32 + wid * 4;
#pragma nounroll
            for (int j = 0; j < 4; ++j) convert_item(Pc, it0 + j, scr, lane);
        } else if (!(layer & 1)) { const int qb = 7 - (int)(ua >> 8), r = ua & 255, kind = r >> 7, b = (r >> 3) & 15, h = r & 7;
            if (kind == 0) { if (EN & 16) attn_unit<0>(P, lj, b, h, qb, lds); } else { if (EN & 32) attn_unit<1>(P, lj, b, h, qb, lds); } }
        else { if (u < 1024u) { const int qb = 15 - (int)(u >> 6), r = u & 63; if (EN & 64) attn_unit<2>(P, lj, r >> 2, r & 3, qb, lds); }
            else { if (qw[8] == 0u) {
                    if (tid == 0) { unsigned sp_ = 0; while (__hip_atomic_load(ctr + 32, __ATOMIC_RELAXED, __HIP_MEMORY_SCOPE_AGENT) < (unsigned)(MTOK / 256)) { __builtin_amdgcn_s_sleep(2); if (++sp_ > (1u << 22)) break; }
                        __builtin_amdgcn_fence(__ATOMIC_ACQUIRE, "agent"); asm volatile("s_waitcnt vmcnt(0)" ::: "memory"); }
                    __syncthreads(); if (tid == 0) qw[8] = 1u; }
              const unsigned v = u - 1024u; const int qb = 31 - (int)(v >> 5), r = v & 31; if (EN & 128) attn_unit<3>(P, lj, r >> 1, r & 1, qb, lds); } }
        if (!pre && tid == 0) nxt = atomicAdd(ctr, 1u) + G;
    }
}

#define XB_TMO      128
#define XB_XCNT(j)  (256  + 64 * (j))
#define XB_XSUB(j)  (1280 + 64 * (j))
#define XB_XGEN(j)  (2304 + 64 * (j))
#define XB_TOP      3328
#define XB_TOPGEN   3392
#define XCD_BAR_WORDS 3456
#define XB_SPIN_CAP (1u << 18)

__device__ __forceinline__ unsigned xb_ld(unsigned* p)              { return __hip_atomic_load(p, __ATOMIC_RELAXED, __HIP_MEMORY_SCOPE_AGENT); }
__device__ __forceinline__ unsigned xb_add(unsigned* p, unsigned v) { return __hip_atomic_fetch_add(p, v, __ATOMIC_RELAXED, __HIP_MEMORY_SCOPE_AGENT); }
__device__ __forceinline__ unsigned xb_xcc_id() { return (unsigned)__builtin_amdgcn_s_getreg((3 << 11) | 20) & 0xFu; }
#define XB_SPIN(cond, bar) do { unsigned _sp = 0; while (cond) { __builtin_amdgcn_s_sleep(1); \
    if ((++_sp & 255u) == 0u) { if (xb_ld(&(bar)[XB_TMO])) break; if (_sp > XB_SPIN_CAP) { atomicAdd(&(bar)[XB_TMO], 1u); break; } } } } while (0)

struct XcdBarrier {
    unsigned* bar; unsigned x;
    volatile LAS unsigned* st;
};

__device__ __forceinline__ XcdBarrier xcd_barrier_post(unsigned* bar, volatile LAS unsigned* st) {
    XcdBarrier b; b.bar = bar; b.x = xb_xcc_id(); b.st = st;
    if (threadIdx.x == 0) (void)xb_add(&bar[XB_XCNT(b.x)], 1u);
    return b;
}
__device__ __forceinline__ void xcd_barrier_complete(unsigned* bar, unsigned x, unsigned& nloc, unsigned& nx) {
    const unsigned G = gridDim.x * gridDim.y * gridDim.z;
    unsigned sum, cnt, mine, sp = 0u;
    for (;;) {
        sum = 0u; cnt = 0u; mine = 0u;
        unsigned cj[16]; { const unsigned* mid = &bar[XB_XCNT(8)];
          asm volatile("global_load_dword %0, %16, off offset:-2048 sc1\n\tglobal_load_dword %1, %16, off offset:-1792 sc1\n\tglobal_load_dword %2, %16, off offset:-1536 sc1\n\tglobal_load_dword %3, %16, off offset:-1280 sc1\n\t"
                       "global_load_dword %4, %16, off offset:-1024 sc1\n\tglobal_load_dword %5, %16, off offset:-768 sc1\n\tglobal_load_dword %6, %16, off offset:-512 sc1\n\tglobal_load_dword %7, %16, off offset:-256 sc1\n\t"
                       "global_load_dword %8, %16, off sc1\n\tglobal_load_dword %9, %16, off offset:256 sc1\n\tglobal_load_dword %10, %16, off offset:512 sc1\n\tglobal_load_dword %11, %16, off offset:768 sc1\n\t"
                       "global_load_dword %12, %16, off offset:1024 sc1\n\tglobal_load_dword %13, %16, off offset:1280 sc1\n\tglobal_load_dword %14, %16, off offset:1536 sc1\n\tglobal_load_dword %15, %16, off offset:1792 sc1\n\t"
                       "s_waitcnt vmcnt(0)"
                       : "=&v"(cj[0]), "=&v"(cj[1]), "=&v"(cj[2]), "=&v"(cj[3]), "=&v"(cj[4]), "=&v"(cj[5]), "=&v"(cj[6]), "=&v"(cj[7]),
                         "=&v"(cj[8]), "=&v"(cj[9]), "=&v"(cj[10]), "=&v"(cj[11]), "=&v"(cj[12]), "=&v"(cj[13]), "=&v"(cj[14]), "=&v"(cj[15])
                       : "v"(mid) : "memory"); }
#pragma unroll
        for (unsigned j = 0; j < 16; ++j) { const unsigned c = cj[j]; sum += c; cnt += (c > 0u) ? 1u : 0u; mine = (j == x) ? c : mine; }
        if (sum == G) break;
        __builtin_amdgcn_s_sleep(1);
        if ((++sp & 255u) == 0u) { if (xb_ld(&bar[XB_TMO])) break; if (sp > XB_SPIN_CAP) { atomicAdd(&bar[XB_TMO], 1u); break; } }
    }
    nloc = mine > 0u ? mine : 1u; nx = cnt > 0u ? cnt : 1u;
}

__device__ __forceinline__ void xcd_barrier(const XcdBarrier& b) {
    asm volatile("s_waitcnt vmcnt(0)" ::: "memory");
    __syncthreads();
    if (threadIdx.x == 0) {
        unsigned* bar = b.bar;
        __builtin_amdgcn_s_waitcnt(0);
        unsigned nloc = b.st[0], nx = b.st[1];
        if (nloc == 0u) { xcd_barrier_complete(bar, b.x, nloc, nx); b.st[0] = nloc; b.st[1] = nx; }
        const unsigned old = xb_add(&bar[XB_XSUB(b.x)], 1u);
        const unsigned gen = old / nloc;
        if (old + 1u == (gen + 1u) * nloc) {
            __builtin_amdgcn_fence(__ATOMIC_RELEASE, "agent");
            asm volatile("s_waitcnt vmcnt(0)" ::: "memory");
            const unsigned og = xb_add(&bar[XB_TOP], 1u);
            const unsigned tg = og / nx;
            if (og + 1u == (tg + 1u) * nx) xb_add(&bar[XB_TOPGEN], 1u);
            else XB_SPIN(xb_ld(&bar[XB_TOPGEN]) == tg, bar);
            __builtin_amdgcn_fence(__ATOMIC_ACQUIRE, "agent");
            xb_add(&bar[XB_XGEN(b.x)], 1u);
            asm volatile("s_waitcnt vmcnt(0)" ::: "memory");
        } else {
            XB_SPIN(xb_ld(&bar[XB_XGEN(b.x)]) == gen, bar);
            __builtin_amdgcn_fence(__ATOMIC_ACQUIRE, "agent");
            asm volatile("s_waitcnt vmcnt(0)" ::: "memory");
        }
    }
    __syncthreads();
}


#ifndef MK_N_LAUNCHES
#define MK_N_LAUNCHES 1
#endif
__global__ void __launch_bounds__(512, 2) mega_fwd(Params Pv) {
    CP P = (CP)__builtin_amdgcn_kernarg_segment_ptr(); (void)Pv;
    extern __shared__ __attribute__((aligned(16))) unsigned char lds_raw[];
    ldsp lds = (ldsp)lds_raw;
    cg::grid_group grid = cg::this_grid();
    unsigned* ctl = (unsigned*)(P->ws + WS_CTL);
    volatile LAS unsigned* bst = (volatile LAS unsigned*)(lds + LDS_QW + 16);
    if (threadIdx.x < 2) bst[threadIdx.x] = 0u;
    __syncthreads();
#if MK_N_LAUNCHES == 1
    for (unsigned i = blockIdx.x * 512u + threadIdx.x; i < CTL_ZERO_BYTES / 4; i += gridDim.x * 512u) ctl[i] = 0u;
    grid.sync();
#endif
    XcdBarrier bar = xcd_barrier_post(ctl + 4096, bst);
    const int ph_lo = P->ph_lo, ph_hi = P->ph_hi;
    for (int ph = ph_lo; ph < ph_hi; ++ph) {
        asm volatile("" : "+s"(P));
        if (ph == 0) { if (EN & 1) phase_prologue(P, lds); }
        else {
            const int layer = (ph - 1) / 3, sub = (ph - 1) % 3, lj = layer >> 1, cd = layer & 1;
            if (sub == 0 || (sub == 1 && cd)) {
                pg8::Gemm g{(const bf16_t*)(P->ws + WS_XB), cd ? (const bf16_t*)(P->ws + WS_WT_CD) + (size_t)lj * CD_N * 1024 : (const bf16_t*)(P->ws + WS_WT_AB) + (size_t)lj * AB_N * 1024, MTOK, cd ? CD_N : AB_N, DM};
                pg8::StaticOrder S; if (sub == 0) S.init(MTOK, cd ? CD_N - 256 : AB_N, (int)gridDim.x, (int)blockIdx.x); else S.init_tail(MTOK, CD_N / 256 - 1, (int)gridDim.x, (int)blockIdx.x);
                pg8::EpiIn E{(bf16_t*)(P->ws + WS_PROJ), cd ? CD_N : AB_N, (const float*)(P->ws + WS_SSQ), cd,
                             cd ? P->diff_q_gain + lj * 64 : P->moba_q_gain + lj * 64, cd ? P->diff_k_gain + lj * 64 : P->moba_k_gain + lj * 64,
                             cd ? P->swa_q_gain + lj * 64 : P->fox_q_gain + lj * 64, cd ? P->swa_k_gain + lj * 64 : P->fox_k_gain + lj * 64,
                             (float*)(P->ws + WS_KMEAN), (LAS float*)(lds + LDS_MISC)};
                { const int t = opaque_tid();
                  if (t < 256) { const float* gp = t < 64 ? E.gq0 : t < 128 ? E.gk0 : t < 192 ? E.gq1 : E.gk1; ((LAS float*)(lds + LDS_MISC + 8192))[t] = gp[t & 63]; }
                  __syncthreads(); }
                if (EN & 2) pg8::gemm_phase<pg8::EpiIn, pg8::StaticOrder, true, true>(lds, g, S, E);
                if (sub == 0) { if (EN & 4) if (!cd) fgate_pass(P, lj, lds); }
                else {
                    const int nmine = ((int)blockIdx.x < MTOK / 256) ? (MTOK / 256 - 1 - (int)blockIdx.x) / (int)gridDim.x + 1 : 0;
                    asm volatile("s_waitcnt vmcnt(0)" ::: "memory");
                    __syncthreads();
                    if (nmine > 0 && threadIdx.x == 0) { __builtin_amdgcn_fence(__ATOMIC_RELEASE, "agent"); asm volatile("s_waitcnt vmcnt(0)" ::: "memory"); (void)xb_add(ctl + 64 * (1 + layer) + 32, (unsigned)nmine); }
                }
            }
            if (sub == 1) {
                asm volatile("" : "+s"(P));
                phase_attn(P, layer, lds, ctl + 64 * (1 + layer));
            } else if (sub == 2) {
                pg8::Gemm g{(const bf16_t*)(P->ws + WS_Y), (const bf16_t*)(P->ws + WS_WT_OUT) + (size_t)layer * 1024 * 1024, MTOK, DM, DM};
                pg8::StaticOrder S; S.init(MTOK, DM, (int)gridDim.x, (int)blockIdx.x);
                pg8::EpiOut E{P->x, P->out, (bf16_t*)(P->ws + WS_XB), (float*)(P->ws + WS_SSQ), (LAS float*)(lds + LDS_MISC + 8192), layer};
                if (EN & 8) pg8::gemm_phase<pg8::EpiOut, pg8::StaticOrder, true, true>(lds, g, S, E);
            }
        }
        if (ph + 1 < ph_hi) xcd_barrier(bar);
    }
}

extern "C" void kernel_launch(void* const* d_in, const int* in_sizes, int n_in, void* d_out, int out_size, void* d_ws, size_t ws_size, hipStream_t stream) {
    static int grid = 0;
    if (grid == 0) {
        if (n_in != 18 || in_sizes[0] != MTOK * DM || out_size != MTOK * DM || ws_size < WS_END) { fprintf(stderr, "kernel_launch: unexpected shapes (n_in %d, in0 %d, out %d, ws %zu)\n", n_in, n_in > 0 ? in_sizes[0] : -1, out_size, ws_size); grid = -1; return; }
        int dev = 0, cus = 0, per_cu = 0;
        (void)hipGetDevice(&dev); (void)hipDeviceGetAttribute(&cus, hipDeviceAttributeMultiprocessorCount, dev);
        if (hipFuncSetAttribute((const void*)mega_fwd, hipFuncAttributeMaxDynamicSharedMemorySize, LDS_BYTES) != hipSuccess) { fprintf(stderr, "kernel_launch: hipFuncSetAttribute failed\n"); grid = -1; return; }
        if (hipOccupancyMaxActiveBlocksPerMultiprocessor(&per_cu, (const void*)mega_fwd, 512, LDS_BYTES) != hipSuccess || per_cu < 1) { fprintf(stderr, "kernel_launch: occupancy query says %d\n", per_cu); per_cu = 1; }
        (void)hipGetLastError();
        grid = cus;
    }
    if (grid < 0) return;
#if MK_N_LAUNCHES != 1
    (void)hipMemsetAsync((char*)d_ws + WS_CTL, 0, CTL_ZERO_BYTES, stream);
#endif
    Params p{};
    const float** pp = (const float**)&p;
    for (int i = 0; i < 18; ++i) pp[i] = (const float*)d_in[i];
    p.out = (float*)d_out; p.ws = (unsigned char*)d_ws;
#if MK_N_LAUNCHES == 1
    p.ph_lo = 0; p.ph_hi = NPHASE;
    void* args[] = {&p};
    hipError_t e = hipLaunchCooperativeKernel((const void*)mega_fwd, dim3(grid), dim3(512), args, LDS_BYTES, stream);
    if (e != hipSuccess) fprintf(stderr, "cooperative launch failed: %s (grid %d)\n", hipGetErrorString(e), grid);
#else
    for (int ph = 0; ph < NPHASE; ++ph) { p.ph_lo = ph; p.ph_hi = ph + 1; hipLaunchKernelGGL(mega_fwd, dim3(grid), dim3(512), LDS_BYTES, stream, p); }
#endif
}
```

```cpp
#include <hip/hip_runtime.h>
#include <hip/hip_cooperative_groups.h>
#include <cstdio>
#include <cstdint>
namespace cg = cooperative_groups;
#ifndef EN
#define EN 0xff
#endif

constexpr int BATCH = 16, SEQ = 2048, DM = 1024, MTOK = BATCH * SEQ;
constexpr int AB_N = 4096, AB_SRC = 4104, CD_N = 3328;
constexpr float EPS = 1e-6f;
constexpr float LOG2E = 1.4426950408889634f;
constexpr float QSCALE = 0.125f * LOG2E;
__device__ __forceinline__ int opaque_tid() { int t = (int)threadIdx.x; asm volatile("" : "+v"(t)); return t; }

typedef unsigned xl_u2 __attribute__((ext_vector_type(2)));
template <int CTRL> __device__ __forceinline__ float dppf(float x) { return __int_as_float(__builtin_amdgcn_update_dpp(0, __float_as_int(x), CTRL, 0xf, 0xf, false)); }
__device__ __forceinline__ float rsum16(float x) { x += dppf<0x128>(x); x += dppf<0x124>(x); x += dppf<0x122>(x); x += dppf<0x121>(x); return x; }
__device__ __forceinline__ float rmax16(float x) { x = fmaxf(x, dppf<0x128>(x)); x = fmaxf(x, dppf<0x124>(x)); x = fmaxf(x, dppf<0x122>(x)); x = fmaxf(x, dppf<0x121>(x)); return x; }
__device__ __forceinline__ float rmin16(float x) { x = fminf(x, dppf<0x128>(x)); x = fminf(x, dppf<0x124>(x)); x = fminf(x, dppf<0x122>(x)); x = fminf(x, dppf<0x121>(x)); return x; }
__device__ __forceinline__ float xadd32(float x) { const xl_u2 r = __builtin_amdgcn_permlane32_swap(__float_as_uint(x), __float_as_uint(x), false, false); return __uint_as_float(r[0]) + __uint_as_float(r[1]); }
__device__ __forceinline__ float xadd16(float x) { const xl_u2 r = __builtin_amdgcn_permlane16_swap(__float_as_uint(x), __float_as_uint(x), false, false); return __uint_as_float(r[0]) + __uint_as_float(r[1]); }
__device__ __forceinline__ float xmax32(float x) { const xl_u2 r = __builtin_amdgcn_permlane32_swap(__float_as_uint(x), __float_as_uint(x), false, false); return fmaxf(__uint_as_float(r[0]), __uint_as_float(r[1])); }
__device__ __forceinline__ float xmax16(float x) { const xl_u2 r = __builtin_amdgcn_permlane16_swap(__float_as_uint(x), __float_as_uint(x), false, false); return fmaxf(__uint_as_float(r[0]), __uint_as_float(r[1])); }
__device__ __forceinline__ float xmin16(float x) { const xl_u2 r = __builtin_amdgcn_permlane16_swap(__float_as_uint(x), __float_as_uint(x), false, false); return fminf(__uint_as_float(r[0]), __uint_as_float(r[1])); }
namespace pg8 {
#define PG8_LAS __attribute__((address_space(3)))
typedef unsigned short bf16_t;
typedef short bf16x8 __attribute__((ext_vector_type(8)));
typedef float f32x4 __attribute__((ext_vector_type(4)));
typedef unsigned u32x4 __attribute__((ext_vector_type(4)));
constexpr int BM = 256, BK = 64, HALF = 128, HTB = HALF * BK * 2  , STAGE_BYTES = 8 * HTB, NXCD = 8, WGM = 4;

__host__ __device__ __forceinline__ int lds_byte(int r, int c) { const int st = (r >> 4) * 2 + (c >> 5), rr = r & 15, cc = c & 31, ob = rr * 64 + cc * 2; return st * 1024 + (ob ^ (((ob >> 9) & 1) << 5)); }
__host__ __device__ __forceinline__ void stage_rc(int b, int& R, int& C) { const int st = b / 1024, sb = b % 1024, swz = sb ^ (((sb >> 9) & 1) << 5); R = (st >> 1) * 16 + swz / 64; C = (st & 1) * 32 + (swz % 64) / 2; }
__host__ __device__ __forceinline__ int perm32(int rho) { const int n = rho >> 4, i = rho & 15; return 8 * (i >> 2) + 4 * n + (i & 3); }

struct Unit { int pm, pn; };
struct Gemm { const bf16_t* A; const bf16_t* Bt; int M, N, K; };

struct StaticOrder {
    int nM, nN, nwg, G, c;
    __host__ __device__ void init(int M, int N, int G_, int c_) { nM = M / BM; nN = N / BM; nwg = nM * nN; G = G_; c = c_; }
    __host__ __device__ void init_tail(int M, int pn, int G_, int c_) { nM = M / BM; nN = -pn; nwg = nM; G = G_; c = c_; }
    __host__ __device__ bool next(int i, Unit& u) const {
        const long L = (long)i * G + c; if (L >= nwg) return false;
        if (nN < 0) { u.pm = (int)L; u.pn = -nN; return true; }
        int wgid = (int)L; { const int q = nwg / NXCD, r = nwg % NXCD, xcd = wgid % NXCD, off = wgid / NXCD; wgid = (xcd < r ? xcd * (q + 1) : r * (q + 1) + (xcd - r) * q) + off; }
        const int nig = WGM * nN, gid = wgid / nig, fm = gid * WGM, gsz = (nM - fm) < WGM ? (nM - fm) : WGM;
        u.pm = fm + ((wgid % nig) % gsz); u.pn = (wgid % nig) / gsz; return true;
    }
    __device__ __forceinline__ void a_ready(const Unit&) const {}
    __device__ __forceinline__ void done(const Unit&) const {}
};


__device__ __forceinline__ unsigned cvt_pk_bf16(float lo, float hi) { typedef float f2 __attribute__((ext_vector_type(2))); typedef __bf16 b2 __attribute__((ext_vector_type(2))); f2 v = {lo, hi}; b2 b = __builtin_convertvector(v, b2); return __builtin_bit_cast(unsigned, b); }
#define PG8_EPI_BAR() do { asm volatile("s_waitcnt lgkmcnt(0)" ::: "memory"); __builtin_amdgcn_s_barrier(); asm volatile("" ::: "memory"); } while (0)

struct EpiIn {
    static constexpr bool PERM = true, AFTER_DRAIN = false;
    bf16_t* O; int ldc; const float* ssq; int cd;
    const float* gq0; const float* gk0; const float* gq1; const float* gk1;
    float* kmean; PG8_LAS float* rsl;
    __device__ __forceinline__ void prefetch(const Unit& u, int wid, int lane, int par) const {
        if (wid < 4) { unsigned keep; const void* g = ssq + (size_t)(u.pm * BM + wid * 64 + lane) * 4; const unsigned d = (unsigned)(uintptr_t)rsl + par * 4096 + wid * 1024;
            asm volatile("s_mov_b32 %0, m0\n\ts_mov_b32 m0, %2\n\ts_nop 0\n\tglobal_load_lds_dwordx4 %1, off\n\ts_mov_b32 m0, %0" : "=&s"(keep) : "v"(g), "s"(__builtin_amdgcn_readfirstlane((int)d)) : "memory"); }
    }
    template <int T>
    __device__ __forceinline__ void run(const f32x4 (&acc)[2][2][4][2], const Unit& u, int wr, int wc, int fr, int fq, int par, int gi) const {
        f32x4 gv[2][2];
#pragma unroll
        for (int bj = 0; bj < 2; ++bj)
#pragma unroll
            for (int n = 0; n < 2; ++n) gv[bj][n] = (T >= 2) ? *(const PG8_LAS f32x4*)(rsl + 2048 + gi * 64 + 32 * bj + 8 * fq + 4 * n) : (f32x4){1.f, 1.f, 1.f, 1.f};
        constexpr float qs = (T == 2) ? (0.125f * 1.4426950408889634f) : 1.0f;
        f32x4 cs[2][2];
#pragma unroll
        for (int bj = 0; bj < 2; ++bj)
#pragma unroll
            for (int n = 0; n < 2; ++n) cs[bj][n] = (f32x4){0.f, 0.f, 0.f, 0.f};
#pragma unroll
        for (int ai = 0; ai < 2; ++ai)
#pragma unroll
            for (int m = 0; m < 4; ++m) {
                const int rl = ai * HALF + wr * 64 + m * 16 + fr; const f32x4 s4 = *(const PG8_LAS f32x4*)(rsl + par * 1024 + rl * 4);
                const float rs = __builtin_amdgcn_rsqf(((s4[0] + s4[1]) + (s4[2] + s4[3])) * (1.0f / 1024.0f) + 1e-6f);
                f32x4 v[2][2];
                if constexpr (T >= 2) {
                    f32x4 q4 = acc[ai][0][m][0] * acc[ai][0][m][0];
                    q4 += acc[ai][0][m][1] * acc[ai][0][m][1]; q4 += acc[ai][1][m][0] * acc[ai][1][m][0]; q4 += acc[ai][1][m][1] * acc[ai][1][m][1];
                    float ss = (q4[0] + q4[1]) + (q4[2] + q4[3]);
                    ss = xadd16(ss); ss = xadd32(ss);
                    const float inv = rs * __builtin_amdgcn_rsqf(rs * rs * ss * (1.0f / 64.0f) + 1e-6f) * qs;
#pragma unroll
                    for (int bj = 0; bj < 2; ++bj)
#pragma unroll
                        for (int n = 0; n < 2; ++n) v[bj][n] = acc[ai][bj][m][n] * inv * gv[bj][n];
                    if constexpr (T == 4) {
#pragma unroll
                        for (int bj = 0; bj < 2; ++bj)
#pragma unroll
                            for (int n = 0; n < 2; ++n) cs[bj][n] += v[bj][n];
                    }
                } else if constexpr (T == 1) {
                    const float nrs = rs * -1.4426950408889634f;
#pragma unroll
                    for (int bj = 0; bj < 2; ++bj)
#pragma unroll
                        for (int n = 0; n < 2; ++n) { const f32x4 x = acc[ai][bj][m][n] * rs; f32x4 e = acc[ai][bj][m][n] * nrs;
#pragma unroll
                            for (int c = 0; c < 4; ++c) e[c] = __builtin_amdgcn_exp2f(e[c]);
                            e += (f32x4){1.f, 1.f, 1.f, 1.f};
#pragma unroll
                            for (int c = 0; c < 4; ++c) e[c] = __builtin_amdgcn_rcpf(e[c]);
                            v[bj][n] = x * e; }
                } else {
#pragma unroll
                    for (int bj = 0; bj < 2; ++bj)
#pragma unroll
                        for (int n = 0; n < 2; ++n) v[bj][n] = acc[ai][bj][m][n] * rs;
                }
                bf16_t* rowp = O + (size_t)(u.pn * 4 + wc) * ((size_t)32768 * 64) + (size_t)(u.pm * BM + rl) * 64 + 8 * fq;
#pragma unroll
                for (int bj = 0; bj < 2; ++bj) { u32x4 w; w.x = cvt_pk_bf16(v[bj][0][0], v[bj][0][1]); w.y = cvt_pk_bf16(v[bj][0][2], v[bj][0][3]); w.z = cvt_pk_bf16(v[bj][1][0], v[bj][1][1]); w.w = cvt_pk_bf16(v[bj][1][2], v[bj][1][3]);
                    *(u32x4*)(rowp + bj * 32) = w; }
            }
        if constexpr (T == 4) {
            const int head = (u.pn & 1) * 4 + wc;
#pragma unroll
            for (int bj = 0; bj < 2; ++bj)
#pragma unroll
                for (int n = 0; n < 2; ++n)
#pragma unroll
                    for (int e = 0; e < 4; ++e) cs[bj][n][e] = rsum16(cs[bj][n][e]);
            if (fr == 0) { float* kp = kmean + ((size_t)(u.pm * 2 + wr) * 8 + head) * 64 + 8 * fq;
#pragma unroll
                for (int bj = 0; bj < 2; ++bj)
#pragma unroll
                    for (int n = 0; n < 2; ++n) *(f32x4*)(kp + 32 * bj + 4 * n) = cs[bj][n]; }
        }
    }
    __device__ __forceinline__ void operator()(const f32x4 (&acc)[2][2][4][2], const Unit& u, int wr, int wc, int fr, int fq, int par) const {
        int type = 0; int gain = 0;
        if (!cd) { const int seg = u.pn >> 1;
            if (seg == 0) { type = 2; gain = 0; } else if (seg == 1) { type = 4; gain = 1; } else if (seg == 3 || seg == 7) type = 1;
            else if (seg == 4) { type = 2; gain = 2; } else if (seg == 5) { type = 3; gain = 3; } }
        else { const int pn = u.pn;
            if (pn < 2) { type = 2; gain = 0; } else if (pn < 4) { type = 3; gain = 1; } else if (pn < 6) type = 0; else if (pn < 8) type = 1;
            else if (pn < 10) { type = 2; gain = 2; } else if (pn == 10) { if (wc < 2) { type = 3; gain = 3; } } else type = 1; }
        type = __builtin_amdgcn_readfirstlane(type);
        if (type == 0) run<0>(acc, u, wr, wc, fr, fq, par, gain);
        else if (type == 1) run<1>(acc, u, wr, wc, fr, fq, par, gain);
        else if (type == 2) run<2>(acc, u, wr, wc, fr, fq, par, gain);
        else if (type == 3) run<3>(acc, u, wr, wc, fr, fq, par, gain);
        else run<4>(acc, u, wr, wc, fr, fq, par, gain);
    }
};

struct EpiOut {
    static constexpr bool PERM = true, AFTER_DRAIN = false;
    const float* xin; float* xout; bf16_t* xb; float* ssq; PG8_LAS float* part; int layer;
    __device__ __forceinline__ void prefetch(const Unit&, int, int, int) const {}
    template <int KIND>
    __device__ __forceinline__ void run(const f32x4 (&acc)[2][2][4][2], const Unit& u, int wr, int wc, int fr, int fq) const {
        const int tid = opaque_tid();
        const int col0 = u.pn * BM + wc * 32 + 8 * fq;
        constexpr int NB = (KIND == 0) ? 2 : 1, AIB = 2 / NB;
#pragma unroll
        for (int b = 0; b < NB; ++b) {
            f32x4 xf[(KIND == 0) ? 1 : 1][(KIND == 0) ? 4 : 1][2][2]; u32x4 xw[(KIND == 0) ? 1 : 2][4][2];
#pragma unroll
            for (int a = 0; a < AIB; ++a)
#pragma unroll
                for (int m = 0; m < 4; ++m)
#pragma unroll
                    for (int bj = 0; bj < 2; ++bj) { const int ai = b * AIB + a; const size_t off = (size_t)(u.pm * BM + ai * HALF + wr * 64 + m * 16 + fr) * 1024 + col0 + bj * HALF;
                        if constexpr (KIND == 0) { xf[0][m][bj][0] = *(const f32x4*)(xin + off); xf[0][m][bj][1] = *(const f32x4*)(xin + off + 4); }
                        else xw[a][m][bj] = *(const u32x4*)(xb + off); }
            asm volatile("" ::: "memory");
#pragma unroll
            for (int a = 0; a < AIB; ++a)
#pragma unroll
                for (int m = 0; m < 4; ++m) { const int ai = b * AIB + a;
                    const int rl = ai * HALF + wr * 64 + m * 16 + fr; const size_t off = (size_t)(u.pm * BM + rl) * 1024 + col0;
                    float ss = 0.f;
#pragma unroll
                    for (int bj = 0; bj < 2; ++bj) {
                        f32x4 x0, x1;
                        if constexpr (KIND == 0) { x0 = xf[0][m][bj][0]; x1 = xf[0][m][bj][1]; }
                        else { const u32x4 w = xw[a][m][bj];
                            x0 = (f32x4){__uint_as_float(w.x << 16), __uint_as_float(w.x & 0xffff0000u), __uint_as_float(w.y << 16), __uint_as_float(w.y & 0xffff0000u)};
                            x1 = (f32x4){__uint_as_float(w.z << 16), __uint_as_float(w.z & 0xffff0000u), __uint_as_float(w.w << 16), __uint_as_float(w.w & 0xffff0000u)}; }
                        const f32x4 v0 = acc[ai][bj][m][0] + x0, v1 = acc[ai][bj][m][1] + x1;
                        if constexpr (KIND == 2) { *(f32x4*)(xout + off + bj * HALF) = v0; *(f32x4*)(xout + off + bj * HALF + 4) = v1; }
                        else {
                            u32x4 w; w.x = cvt_pk_bf16(v0[0], v0[1]); w.y = cvt_pk_bf16(v0[2], v0[3]); w.z = cvt_pk_bf16(v1[0], v1[1]); w.w = cvt_pk_bf16(v1[2], v1[3]);
                            *(u32x4*)(xb + off + bj * HALF) = w;
                            const float r0 = __uint_as_float(w.x << 16), r1 = __uint_as_float(w.x & 0xffff0000u), r2 = __uint_as_float(w.y << 16), r3 = __uint_as_float(w.y & 0xffff0000u);
                            const float r4 = __uint_as_float(w.z << 16), r5 = __uint_as_float(w.z & 0xffff0000u), r6 = __uint_as_float(w.w << 16), r7 = __uint_as_float(w.w & 0xffff0000u);
                            ss += (r0 * r0 + r1 * r1) + (r2 * r2 + r3 * r3) + (r4 * r4 + r5 * r5) + (r6 * r6 + r7 * r7);
                        }
                    }
                    if constexpr (KIND != 2) { ss = xadd16(ss); ss = xadd32(ss); if (fq == 0) part[rl * 4 + wc] = ss; }
                }
        }
        PG8_EPI_BAR();
        if (KIND != 2 && tid < 256) { const f32x4 p4 = *(const PG8_LAS f32x4*)(part + tid * 4); ssq[(size_t)(u.pm * BM + tid) * 4 + u.pn] = (p4[0] + p4[1]) + (p4[2] + p4[3]); }
    }
    __device__ __forceinline__ void operator()(const f32x4 (&acc)[2][2][4][2], const Unit& u, int wr, int wc, int fr, int fq, int) const {
        if (layer == 0) run<0>(acc, u, wr, wc, fr, fq); else if (layer == 3) run<2>(acc, u, wr, wc, fr, fq); else run<1>(acc, u, wr, wc, fr, fq);
    }
};

template <class Epi, class Sched, bool ALIGN_EPI = false, bool SP2 = false>
__device__ __forceinline__ void gemm_phase(PG8_LAS unsigned char* lds, const Gemm g, const Sched& S, const Epi& E) {
    const int tid = opaque_tid(), wid = __builtin_amdgcn_readfirstlane(tid >> 6), lane = tid & 63, wr = wid >> 2, wc = wid & 3, fr = lane & 15, fq = lane >> 4;
    const int K = g.K, nt = K / BK;
    unsigned voffA[2], voffB[2];
#pragma unroll
    for (int i = 0; i < 2; ++i) { int R, C; stage_rc(tid * 16 + i * 8192, R, C); const int Rb = Epi::PERM ? ((R & ~31) + perm32(R & 31)) : R;
        voffA[i] = (unsigned)(R * K + C) * 2u; voffB[i] = (unsigned)(Rb * K + C) * 2u; }
    const size_t kstep = (size_t)(BK * 2);
    const size_t hstep = (size_t)HALF * K * 2;
    const size_t tstep = 2 * hstep;
    const unsigned ldsw = (unsigned)wid * 1024u;
    const int aoff = lds_byte(wr * 64 + fr, fq * 8), boff = lds_byte(wc * 32 + fr, fq * 8);
#define PG8_SA(b, h) (((b) * 2 + (h)) * HTB)
#define PG8_SB(b, h) ((4 + (b) * 2 + (h)) * HTB)
#define PG8_STAGE(bufoff, gbase, voff) do { _Pragma("unroll") for (int _i = 0; _i < 2; ++_i) \
        __builtin_amdgcn_global_load_lds((const unsigned*)((const char*)(gbase) + (voff)[_i]), (PG8_LAS unsigned*)(lds + (bufoff) + ldsw + _i * 8192), 16, 0, 0); } while (0)
#define PG8_LDA(dst, b, h) do { _Pragma("unroll") for (int m = 0; m < 4; ++m) _Pragma("unroll") for (int k = 0; k < 2; ++k) dst[m][k] = *(const PG8_LAS bf16x8*)(lds + PG8_SA(b, h) + aoff + m * 2048 + k * 1024); } while (0)
#define PG8_LDB(dst, b, h) do { _Pragma("unroll") for (int n = 0; n < 2; ++n) _Pragma("unroll") for (int k = 0; k < 2; ++k) dst[n][k] = *(const PG8_LAS bf16x8*)(lds + PG8_SB(b, h) + boff + n * 2048 + k * 1024); } while (0)
#define PG8_MMA(ai, bj, At, Bt) do { __builtin_amdgcn_s_setprio(1); _Pragma("unroll") for (int m = 0; m < 4; ++m) _Pragma("unroll") for (int n = 0; n < 2; ++n) _Pragma("unroll") for (int k = 0; k < 2; ++k) \
        acc[ai][bj][m][n] = __builtin_amdgcn_mfma_f32_16x16x32_bf16(Bt[n][k], At[m][k], acc[ai][bj][m][n], 0, 0, 0); __builtin_amdgcn_s_setprio(0); } while (0)
#define PG8_WAIT_V(n) asm volatile("s_waitcnt vmcnt(" #n ")" ::: "memory")
#define PG8_WAIT_L(n) asm volatile("s_waitcnt lgkmcnt(" #n ")" ::: "memory")
#define PG8_BAR __builtin_amdgcn_s_barrier()
#define PG8_SCHED __builtin_amdgcn_sched_barrier(0)
    Unit cur, nxt; int ui = 0;
    if (!S.next(0, cur)) return;
    f32x4 acc[2][2][4][2];
#pragma unroll
    for (int a = 0; a < 2; ++a)
#pragma unroll
        for (int b = 0; b < 2; ++b)
#pragma unroll
            for (int m = 0; m < 4; ++m)
#pragma unroll
                for (int n = 0; n < 2; ++n) acc[a][b][m][n] = (f32x4){0.f, 0.f, 0.f, 0.f};
    bf16x8 At[4][2], B0[2][2], B1[2][2];
    const char* cA = (const char*)g.A + (size_t)cur.pm * tstep; const char* cB = (const char*)g.Bt + (size_t)cur.pn * tstep;
    S.a_ready(cur);
    E.prefetch(cur, wid, lane, 0);
    if constexpr (SP2) {
        PG8_STAGE(PG8_SB(0, 0), cB, voffB); PG8_STAGE(PG8_SB(0, 1), cB + hstep, voffB); PG8_STAGE(PG8_SA(0, 0), cA, voffA); PG8_STAGE(PG8_SA(0, 1), cA + hstep, voffA);
        if (wr == 1) PG8_BAR;
        PG8_WAIT_V(2); PG8_BAR;
        PG8_STAGE(PG8_SB(1, 0), cB + kstep, voffB); PG8_STAGE(PG8_SA(1, 0), cA + kstep, voffA); PG8_STAGE(PG8_SB(1, 1), cB + hstep + kstep, voffB);
        PG8_WAIT_V(6); PG8_BAR;
    } else {
        PG8_STAGE(PG8_SB(0, 0), cB, voffB); PG8_STAGE(PG8_SA(0, 0), cA, voffA); PG8_STAGE(PG8_SB(0, 1), cB + hstep, voffB); PG8_STAGE(PG8_SA(0, 1), cA + hstep, voffA);
        if (wr == 1) PG8_BAR;
        PG8_WAIT_V(4); PG8_BAR;
        PG8_STAGE(PG8_SB(1, 0), cB + kstep, voffB); PG8_STAGE(PG8_SA(1, 0), cA + kstep, voffA); PG8_STAGE(PG8_SB(1, 1), cB + hstep + kstep, voffB);
        PG8_WAIT_V(6); PG8_BAR;
    }
    for (;;) {
        const bool has_next = S.next(ui + 1, nxt);
        const char* nA = has_next ? (const char*)g.A + (size_t)nxt.pm * tstep : cA; const char* nB = has_next ? (const char*)g.Bt + (size_t)nxt.pn * tstep : cB;
        for (int t = 0; t < nt; t += 2) {
            const bool last = (t == nt - 2);
            const char* a1 = cA + (size_t)(t + 1) * kstep;
            const char* a2 = last ? nA : cA + (size_t)(t + 2) * kstep; const char* b2 = last ? nB : cB + (size_t)(t + 2) * kstep;
            const char* a3 = a2 + kstep; const char* b3 = b2 + kstep;
            if (last && has_next) S.a_ready(nxt);
            if constexpr (SP2) {
            PG8_LDB(B0, 0, 0); PG8_LDB(B1, 0, 1); PG8_SCHED; PG8_LDA(At, 0, 0); PG8_STAGE(PG8_SA(1, 1), a1 + hstep, voffA);
            PG8_WAIT_V(8); PG8_WAIT_L(0); PG8_BAR; PG8_MMA(0, 0, At, B0); PG8_MMA(0, 1, At, B1); PG8_BAR; PG8_SCHED;
            PG8_LDA(At, 0, 1); PG8_STAGE(PG8_SB(0, 0), b2, voffB); PG8_STAGE(PG8_SB(0, 1), b2 + hstep, voffB); PG8_STAGE(PG8_SA(0, 0), a2, voffA);
            PG8_WAIT_V(8); PG8_WAIT_L(0); PG8_BAR; PG8_MMA(1, 0, At, B0); PG8_MMA(1, 1, At, B1); PG8_BAR; PG8_SCHED;
            PG8_LDB(B0, 1, 0); PG8_LDB(B1, 1, 1); PG8_SCHED; PG8_LDA(At, 1, 0); PG8_STAGE(PG8_SA(0, 1), a2 + hstep, voffA);
            PG8_WAIT_V(8); PG8_WAIT_L(0); PG8_BAR; PG8_MMA(0, 0, At, B0); PG8_MMA(0, 1, At, B1); PG8_BAR; PG8_SCHED;
            PG8_LDA(At, 1, 1); PG8_STAGE(PG8_SB(1, 0), b3, voffB); PG8_STAGE(PG8_SB(1, 1), b3 + hstep, voffB); PG8_STAGE(PG8_SA(1, 0), a3, voffA);
            PG8_WAIT_V(8); PG8_WAIT_L(0); PG8_BAR; PG8_MMA(1, 0, At, B0); PG8_MMA(1, 1, At, B1); PG8_BAR; PG8_SCHED;
            } else {
            PG8_LDB(B0, 0, 0); PG8_SCHED; PG8_LDA(At, 0, 0); PG8_STAGE(PG8_SA(1, 1), a1 + hstep, voffA);
            PG8_WAIT_L(8); PG8_BAR; PG8_WAIT_L(0); PG8_MMA(0, 0, At, B0); PG8_BAR; PG8_SCHED;
            PG8_LDB(B1, 0, 1); PG8_STAGE(PG8_SB(0, 0), b2, voffB);
            PG8_BAR; PG8_WAIT_L(0); PG8_MMA(0, 1, At, B1); PG8_BAR;
            PG8_LDA(At, 0, 1); PG8_STAGE(PG8_SA(0, 0), a2, voffA);
            PG8_BAR; PG8_WAIT_L(0); PG8_MMA(1, 0, At, B0); PG8_BAR; PG8_SCHED;
            PG8_STAGE(PG8_SB(0, 1), b2 + hstep, voffB);
            PG8_WAIT_V(6); PG8_BAR; PG8_MMA(1, 1, At, B1); PG8_BAR;
            PG8_LDB(B0, 1, 0); PG8_SCHED; PG8_LDA(At, 1, 0); PG8_STAGE(PG8_SA(0, 1), a2 + hstep, voffA);
            PG8_WAIT_L(8); PG8_BAR; PG8_WAIT_L(0); PG8_MMA(0, 0, At, B0); PG8_BAR; PG8_SCHED;
            PG8_LDB(B1, 1, 1); PG8_STAGE(PG8_SB(1, 0), b3, voffB);
            PG8_BAR; PG8_WAIT_L(0); PG8_MMA(0, 1, At, B1); PG8_BAR;
            PG8_LDA(At, 1, 1); PG8_STAGE(PG8_SA(1, 0), a3, voffA);
            PG8_BAR; PG8_WAIT_L(0); PG8_MMA(1, 0, At, B0); PG8_BAR; PG8_SCHED;
            PG8_STAGE(PG8_SB(1, 1), b3 + hstep, voffB);
            PG8_WAIT_V(6); PG8_BAR; PG8_MMA(1, 1, At, B1); PG8_BAR;
            }
        }
        if constexpr (ALIGN_EPI) { if (wr == 0) PG8_BAR; }
        if constexpr (!Epi::AFTER_DRAIN) { E(acc, cur, wr, wc, fr, fq, ui & 1); S.done(cur); }
        if (!has_next) break;
#pragma unroll
        for (int a = 0; a < 2; ++a)
#pragma unroll
            for (int b = 0; b < 2; ++b)
#pragma unroll
                for (int m = 0; m < 4; ++m)
#pragma unroll
                    for (int n = 0; n < 2; ++n) acc[a][b][m][n] = (f32x4){0.f, 0.f, 0.f, 0.f};
        cur = nxt; cA = nA; cB = nB; ++ui;
        E.prefetch(cur, wid, lane, ui & 1);
        if constexpr (ALIGN_EPI) { if (wr == 1) PG8_BAR; }
    }
    PG8_WAIT_V(0);
    if constexpr (!ALIGN_EPI) { if (wr == 0) PG8_BAR; }
    PG8_BAR;
    if constexpr (Epi::AFTER_DRAIN) { E.fused(acc, cur, wr, wc, fr, fq, lds, wid, lane); S.done(cur); }
#undef PG8_SA
#undef PG8_SB
#undef PG8_STAGE
#undef PG8_LDA
#undef PG8_LDB
#undef PG8_MMA
#undef PG8_WAIT_V
#undef PG8_WAIT_L
#undef PG8_BAR
#undef PG8_SCHED
}
}

#define LAS __attribute__((address_space(3)))
typedef LAS unsigned char* ldsp;
typedef unsigned short bf16_t;
typedef short bf16x8 __attribute__((ext_vector_type(8)));
typedef short s16x4 __attribute__((ext_vector_type(4)));
typedef float f32x4 __attribute__((ext_vector_type(4)));
typedef float f32x16 __attribute__((ext_vector_type(16)));
typedef unsigned u32x4 __attribute__((ext_vector_type(4)));
typedef unsigned u32x2 __attribute__((ext_vector_type(2)));

struct Params {
    const float* x; const float* norm_gain; const float* w_in_ab; const float* b_forget;
    const float* moba_q_gain; const float* moba_k_gain; const float* fox_q_gain; const float* fox_k_gain; const float* w_out_ab;
    const float* w_in_cd; const float* diff_q_gain; const float* diff_k_gain; const float* diff_lambda; const float* diff_subln_gain;
    const float* swa_q_gain; const float* swa_k_gain; const float* swa_sinks; const float* w_out_cd;
    float* out; unsigned char* ws; int ph_lo, ph_hi;
};
typedef const __attribute__((address_space(4))) Params* CP;
constexpr size_t MiB = 1u << 20;
constexpr size_t WS_CTL = 0, CTL_ZERO_BYTES = 128 * 1024;
constexpr int CW_PANEL = 16384;
constexpr size_t WS_WT_AB = 2 * MiB, WS_WT_CD = 18 * MiB, WS_WT_OUT = 32 * MiB, WS_WF = 40 * MiB, WS_SSQ = 41 * MiB, WS_LOGF = 43 * MiB, WS_KMEAN = 44 * MiB;
constexpr size_t WS_XB = 48 * MiB, WS_Y = 112 * MiB, WS_PROJ = 176 * MiB, WS_END = 432 * MiB;
constexpr int LDS_RING = 131072, LDS_MISC = 131072, LDS_BYTES = 155648, LDS_QW = LDS_BYTES - 64;
constexpr int NPHASE = 13;
constexpr size_t HB = (size_t)MTOK * 64;

__device__ __forceinline__ float wave_sum(float v) {
    v = rsum16(v); v = xadd16(v); v = xadd32(v);
    return v;
}
__device__ __forceinline__ float wave_max(float v) {
    v = rmax16(v); v = xmax16(v); v = xmax32(v);
    return v;
}
__device__ __forceinline__ float bf2f(unsigned short b) { return __uint_as_float((unsigned)b << 16); }
__device__ __forceinline__ unsigned pk_bf16(float lo, float hi) { return pg8::cvt_pk_bf16(lo, hi); }

__device__ __forceinline__ void transpose_item(const float* W, int ldw, int k0, int nsrc0, const float* gain, bf16_t* WT, int ndst0, LAS float* scr, int lane) {
    float wv[32];
#pragma unroll
    for (int i = 0; i < 32; ++i) { const int kk = 2 * i + (lane >> 5); wv[i] = W[(size_t)(k0 + kk) * ldw + nsrc0 + (lane & 31)]; }
    const float g0 = gain ? gain[k0 + (lane & 63)] : 1.0f;
#pragma unroll
    for (int i = 0; i < 32; ++i) { const int kk = 2 * i + (lane >> 5); scr[kk * 33 + (lane & 31)] = wv[i] * __shfl(g0, kk); }
    asm volatile("s_waitcnt lgkmcnt(0)" ::: "memory");
    const int c = lane & 7;
#pragma unroll
    for (int j = 0; j < 4; ++j) { const int n = (lane >> 3) + 8 * j; const LAS float* s = scr + (8 * c) * 33 + n;
        u32x4 o; o.x = pk_bf16(s[0 * 33], s[1 * 33]); o.y = pk_bf16(s[2 * 33], s[3 * 33]); o.z = pk_bf16(s[4 * 33], s[5 * 33]); o.w = pk_bf16(s[6 * 33], s[7 * 33]);
        *(u32x4*)(WT + (size_t)(ndst0 + n) * 1024 + k0 + 8 * c) = o; }
    asm volatile("s_waitcnt lgkmcnt(0)" ::: "memory");
}
__device__ __forceinline__ int logical_group(int nbp) { const int pn = nbp >> 3, bj = (nbp >> 2) & 1, wc = nbp & 3; return pn * 8 + wc * 2 + bj; }

constexpr int I_AB = 16 * 128, I_CD = 16 * 104, I_OUT = 16 * 32, NIT = 2 * I_AB + 2 * I_CD + 4 * I_OUT, CONV_DEFER = NIT - I_AB, CONV_TICKETS = CONV_DEFER / 32;
static_assert(CONV_DEFER % 32 == 0, "conversion tickets");
__device__ __forceinline__ void convert_item(CP P, int it, LAS float* scr, int lane) {
        int r = it;
        if (r < 2 * I_AB) { const int l = r / I_AB; r -= l * I_AB; const int kb = r / 128, nbp = r % 128;
            transpose_item(P->w_in_ab + (size_t)l * 1024 * AB_SRC, AB_SRC, kb * 64, logical_group(nbp) * 32, P->norm_gain + (2 * l) * 1024, (bf16_t*)(P->ws + WS_WT_AB) + (size_t)l * AB_N * 1024, nbp * 32, scr, lane); return; }
        r -= 2 * I_AB;
        if (r < 2 * I_CD) { const int l = r / I_CD; r -= l * I_CD; const int kb = r / 104, nbp = r % 104;
            transpose_item(P->w_in_cd + (size_t)l * 1024 * CD_N, CD_N, kb * 64, logical_group(nbp) * 32, P->norm_gain + (2 * l + 1) * 1024, (bf16_t*)(P->ws + WS_WT_CD) + (size_t)l * CD_N * 1024, nbp * 32, scr, lane); return; }
        r -= 2 * I_CD;
        { const int L = r / I_OUT; r -= L * I_OUT; const int kb = r / 32, nb = r % 32;
            const float* W = (L & 1) ? P->w_out_cd + (size_t)(L >> 1) * 1024 * 1024 : P->w_out_ab + (size_t)(L >> 1) * 1024 * 1024;
            transpose_item(W, 1024, kb * 64, nb * 32, nullptr, (bf16_t*)(P->ws + WS_WT_OUT) + (size_t)L * 1024 * 1024, nb * 32, scr, lane); }
}
__device__ __forceinline__ void phase_prologue(CP P, ldsp lds) {
    const int tid = opaque_tid(), lane = tid & 63, wid = tid >> 6;
    const int gw = blockIdx.x * 8 + wid, NGW = gridDim.x * 8;
    LAS float* scr = (LAS float*)(lds + wid * 16384);
    for (int it = gw; it < I_AB; it += NGW) convert_item(P, it, scr, lane);
    { bf16_t* WF = (bf16_t*)(P->ws + WS_WF);
      for (int i = blockIdx.x * 512 + tid; i < 2 * 16 * 1024; i += gridDim.x * 512) { const int l = i >> 14, j = (i >> 10) & 15, k = i & 1023;
          const float w = (j < 8) ? P->w_in_ab[((size_t)l * 1024 + k) * AB_SRC + 4096 + j] * P->norm_gain[(2 * l) * 1024 + k] : 0.f;
          const unsigned h = pk_bf16(w, 0.f) & 0xffffu; const float wl = w - __uint_as_float(h << 16);
          WF[(size_t)(l * 2 + 0) * 16384 + j * 1024 + k] = (bf16_t)h; WF[(size_t)(l * 2 + 1) * 16384 + j * 1024 + k] = (bf16_t)(pk_bf16(wl, 0.f) & 0xffffu); } }
    { bf16_t* XB = (bf16_t*)(P->ws + WS_XB); float* SSQ = (float*)(P->ws + WS_SSQ);
      for (int m0 = gw; m0 < MTOK; m0 += 4 * NGW) {
          f32x4 v[4][4];
#pragma unroll
          for (int q = 0; q < 4; ++q) { const int mq = (m0 + q * NGW < MTOK) ? m0 + q * NGW : m0; const f32x4* xr = (const f32x4*)(P->x + (size_t)mq * DM) + lane;
#pragma unroll
              for (int j = 0; j < 4; ++j) v[q][j] = xr[64 * j]; }
#pragma unroll
          for (int q = 0; q < 4; ++q) { const int m = m0 + q * NGW; if (m >= MTOK) break; float s = 0.f;
#pragma unroll
              for (int j = 0; j < 4; ++j) s += (v[q][j][0] * v[q][j][0] + v[q][j][1] * v[q][j][1]) + (v[q][j][2] * v[q][j][2] + v[q][j][3] * v[q][j][3]);
              s = wave_sum(s);
              if (lane == 0) *(f32x4*)(SSQ + (size_t)m * 4) = (f32x4){s, 0.f, 0.f, 0.f};
              u32x2* o8 = (u32x2*)(XB + (size_t)m * DM) + lane;
#pragma unroll
              for (int j = 0; j < 4; ++j) { u32x2 w; w.x = pk_bf16(v[q][j][0], v[q][j][1]); w.y = pk_bf16(v[q][j][2], v[q][j][3]); o8[64 * j] = w; } }
      } }
}

__device__ __forceinline__ void fgate_pass(CP P, int lj, ldsp lds) {
    typedef float f32x4v __attribute__((ext_vector_type(4)));
    const int tid = opaque_tid(), lane = tid & 63, wid = tid >> 6;
    const int gw = blockIdx.x * 8 + wid, NGW = gridDim.x * 8;
    const bf16_t* XB = (const bf16_t*)(P->ws + WS_XB); const float* SSQ = (const float*)(P->ws + WS_SSQ); float* LOGF = (float*)(P->ws + WS_LOGF);
    const int fr = lane & 15, fq = lane >> 4;
    const float bfj = (fr < 8) ? P->b_forget[lj * 8 + fr] : 0.f;
    constexpr int WROW = 2064;
    __syncthreads();
    { const u32x4* src = (const u32x4*)((const bf16_t*)(P->ws + WS_WF) + (size_t)lj * 2 * 16384);
#pragma unroll
      for (int j = 0; j < 8; ++j) { const int i = tid + 512 * j, row = i >> 7, ch = i & 127; *(LAS u32x4*)(lds + row * WROW + ch * 16) = src[i]; } }
    __syncthreads();
    for (int rg = gw; rg < MTOK / 16; rg += NGW) {
        const bf16_t* xa = XB + (size_t)(rg * 16 + fr) * DM + fq * 8;
        bf16x8 av[32];
#pragma unroll
        for (int ks = 0; ks < 32; ++ks) av[ks] = *(const bf16x8*)(xa + ks * 32);
        f32x4 s4[4];
#pragma unroll
        for (int j = 0; j < 4; ++j) s4[j] = *(const f32x4*)(SSQ + (size_t)(rg * 16 + 4 * fq + j) * 4);
        const unsigned wb = (unsigned)(uintptr_t)lds + fr * WROW + fq * 16;
        f32x4v acc = (f32x4v){0.f, 0.f, 0.f, 0.f};
#pragma unroll
        for (int c = 0; c < 8; ++c) {
            bf16x8 bh[4], bl[4];
#pragma unroll
            for (int i = 0; i < 4; ++i) { const int ks = 4 * c + i; bh[i] = *(const LAS bf16x8*)(wb + ks * 64); bl[i] = *(const LAS bf16x8*)(wb + 16 * WROW + ks * 64); }
#pragma unroll
            for (int i = 0; i < 4; ++i) { const int ks = 4 * c + i; acc = __builtin_amdgcn_mfma_f32_16x16x32_bf16(av[ks], bh[i], acc, 0, 0, 0); acc = __builtin_amdgcn_mfma_f32_16x16x32_bf16(av[ks], bl[i], acc, 0, 0, 0); }
            __builtin_amdgcn_sched_barrier(0);
        }
        if (fr < 8) {
#pragma unroll
            for (int j = 0; j < 4; ++j) { const int row = rg * 16 + 4 * fq + j;
                const float rs = 1.0f / sqrtf(((s4[j][0] + s4[j][1]) + (s4[j][2] + s4[j][3])) * (1.0f / 1024.0f) + EPS);
                const float z = acc[j] * rs + bfj; const float lf = fminf(z, 0.f) - log1pf(expf(-fabsf(z)));
                LOGF[((size_t)(row >> 11) * 8 + fr) * SEQ + (row & 2047)] = lf; }
        }
    }
}

__device__ __forceinline__ void glds16(const void* gsrc, unsigned lds_dst) { unsigned keep;
    asm volatile("s_mov_b32 %0, m0\n\ts_mov_b32 m0, %2\n\ts_nop 0\n\tglobal_load_lds_dwordx4 %1, off\n\ts_mov_b32 m0, %0" : "=&s"(keep) : "v"(gsrc), "s"(lds_dst) : "memory"); }
__device__ __forceinline__ float fadd_s(float a, float b) { asm("" : "+v"(b)); return a + b; }
__device__ __forceinline__ int crow(int r, int hi) { return (r & 3) + 8 * (r >> 2) + 4 * hi; }
__device__ __forceinline__ s16x4 vtr(unsigned addr) { typedef short v4i16_t __attribute__((ext_vector_type(4))); return __builtin_bit_cast(s16x4, __builtin_amdgcn_ds_read_tr16_b64_v4i16((LAS v4i16_t*)addr)); }

template <int VAR>
__device__ __forceinline__ void attn_unit(CP P, int lj, int ub, int uh, int uq, ldsp lds) {
    constexpr int DV = (VAR == 2) ? 128 : 64, NDB = DV / 32, NP = (VAR == 2) ? 2 : 1;
#define HM(row, col) ((size_t)((col) >> 6) * HB + (size_t)(row) * 64 + ((col) & 63))
    constexpr int KTB = (VAR == 2) ? 16384 : 8192, VTB = KTB;
    constexpr bool PIPE = (VAR < 2);
    constexpr int GP = DV * 2, GSB = 32 * GP;
    constexpr int DPF = PIPE ? 4 : 2, NS = PIPE ? DPF + 2 : DPF + 1, SLOT = KTB + VTB;
    constexpr int RINGB = (NS * SLOT < 65536) ? 65536 : NS * SLOT;
    constexpr int L_AUX = RINGB, L_WS = L_AUX + 8192, L_G = L_WS + 2048;
    static_assert(L_G + ((VAR == 2) ? 4 : 8) * GSB <= LDS_QW, "attention LDS map");
    const int tid = opaque_tid(), lane = tid & 63, wid = __builtin_amdgcn_readfirstlane(tid >> 6), r32 = lane & 31, hi = lane >> 5;
    const bf16_t* proj = (const bf16_t*)(P->ws + WS_PROJ);
    bf16_t* Y = (bf16_t*)(P->ws + WS_Y);
    const size_t rowb = (size_t)ub * SEQ;
    int colQ, colK, colV, colG, colY, wq0, t_lo, t_hi; float slope2 = 0.f; const float *gqp, *gkp;
    if constexpr (VAR == 0) { colQ = uh * 64; colK = 512 + uh * 64; colV = 1024 + uh * 64; colG = 1536 + uh * 64; colY = uh * 64; wq0 = uq * 256 + wid * 32; t_lo = 0; t_hi = 4 * uq + 4;
        slope2 = exp2f(-(float)(uh + 1)) * LOG2E; gqp = P->moba_q_gain + lj * 64; gkp = P->moba_k_gain + lj * 64; }
    else if constexpr (VAR == 1) { colQ = 2048 + uh * 64; colK = 2560 + uh * 64; colV = 3072 + uh * 64; colG = 3584 + uh * 64; colY = 512 + uh * 64; wq0 = uq * 256 + wid * 32; t_lo = 0; t_hi = 4 * uq + 4;
        gqp = P->fox_q_gain + lj * 64; gkp = P->fox_k_gain + lj * 64; }
    else if constexpr (VAR == 2) { const int c = wid & 1; colQ = uh * 128 + c * 64; colK = 512 + uh * 128; colV = 1024 + uh * 128; colG = 1536 + uh * 128; colY = uh * 128; wq0 = uq * 128 + (wid >> 1) * 32; t_lo = 0; t_hi = 2 * uq + 2;
        slope2 = exp2f(-2.0f * (float)(uh + 1)) * LOG2E; gqp = P->diff_q_gain + lj * 64; gkp = P->diff_k_gain + lj * 64; }
    else { const int hq = 4 * uh + (wid & 3); colQ = 2048 + hq * 64; colK = 2560 + uh * 64; colV = 2688 + uh * 64; colG = 2816 + hq * 64; colY = 512 + hq * 64; wq0 = uq * 64 + (wid >> 2) * 32; t_lo = uq >= 2 ? uq - 2 : 0; t_hi = uq + 1;
        slope2 = exp2f(-(float)(hq + 1)) * LOG2E; gqp = P->swa_q_gain + lj * 64; gkp = P->swa_k_gain + lj * 64; }
    const int t = wq0 + r32;
    const int twmin = wq0, twmax = wq0 + 31;
    const unsigned lds0 = (unsigned)(uintptr_t)lds;
    const int krow = 8 * wid + (lane >> 3);
    const bf16_t* kgd = proj + HM(rowb + krow, colK) + (((lane & 7) ^ ((krow >> 1) & 7)) * 8);
    const bf16_t* vgd = proj + HM(rowb + 16 * (wid & 3) + (lane >> 2), colV) + (wid >> 2) * 32 + (lane & 3) * 8;
    const int n_hi = t_hi - 1;
#define DMA_TILE(j, slot) do { int tj_ = n_hi - (j); tj_ = tj_ < t_lo ? t_lo : tj_; const size_t ro_ = (size_t)tj_ * 64 * 64; const unsigned sl_ = (unsigned)(slot) * SLOT + wid * 1024; \
        _Pragma("unroll") for (int p_ = 0; p_ < NP; ++p_) glds16(kgd + ro_ + p_ * HB, (unsigned)__builtin_amdgcn_readfirstlane((int)(lds0 + sl_ + p_ * 8192))); \
        _Pragma("unroll") for (int p_ = 0; p_ < NP; ++p_) glds16(vgd + ro_ + p_ * HB, (unsigned)__builtin_amdgcn_readfirstlane((int)(lds0 + sl_ + KTB + p_ * 8192))); } while (0)
#pragma unroll
    for (int j = 0; j < 2; ++j) DMA_TILE(j, j);
    bf16x8 qr[4];
    { const bf16_t* qrow = proj + HM(rowb + t, colQ);
#pragma unroll
      for (int d0 = 0; d0 < 4; ++d0) qr[d0] = *(const bf16x8*)(qrow + d0 * 16 + hi * 8); }
    const unsigned gbase = lds0 + L_G + ((VAR == 2) ? (wid >> 1) : wid) * GSB;
    float gqv, gkv;
    float sinkv = 0.f; if constexpr (VAR == 3) sinkv = P->swa_sinks[lj * 8 + 4 * uh + (wid & 3)];
    f32x4 lfv = (f32x4){0.f, 0.f, 0.f, 0.f}; float km0 = 0.f, km1 = 0.f;
    if constexpr (VAR == 1) lfv = *(const f32x4*)((const float*)(P->ws + WS_LOGF) + ((size_t)ub * 8 + uh) * SEQ + 4 * tid);
    if constexpr (VAR == 0) { const float* kp = (const float*)(P->ws + WS_KMEAN); const int n = tid >> 6, d = tid & 63;
        km0 = kp[((size_t)((ub * 8 + n) * 2 + 0) * 8 + uh) * 64 + d]; km1 = kp[((size_t)((ub * 8 + n) * 2 + 1) * 8 + uh) * 64 + d]; }
    { const float gq_ = gqp[lane], gk_ = gkp[lane];
      __builtin_amdgcn_sched_barrier(0);
      gqv = gq_; gkv = gk_; }
    const float M0 = 8.0f * wave_max(fabsf(gqv)) * wave_max(fabsf(gkv)) * LOG2E;
    unsigned sel = 0u; float cst = 0.f;
    if constexpr (VAR == 0) {
        if (uq >= 4) {
            LAS float* km = (LAS float*)(lds + L_AUX);
            if (tid < uq * 64) km[tid] = (km0 + km1) * (1.0f / 256.0f);
            __syncthreads();
            float g[7];
#pragma unroll
            for (int n = 0; n < 7; ++n) { float a = 0.f;
                if (n < uq) {
#pragma unroll
                    for (int d0 = 0; d0 < 4; ++d0) { const f32x4 k0 = *(const LAS f32x4*)(km + n * 64 + d0 * 16 + hi * 8), k1 = *(const LAS f32x4*)(km + n * 64 + d0 * 16 + hi * 8 + 4);
#pragma unroll
                        for (int e = 0; e < 4; ++e) { a += bf2f((unsigned short)qr[d0][e]) * k0[e]; a += bf2f((unsigned short)qr[d0][4 + e]) * k1[e]; } }
                }
                a = xadd32(a); g[n] = a; }
#pragma unroll
            for (int pick = 0; pick < 3; ++pick) { float best = -INFINITY; int bi = -1;
#pragma unroll
                for (int n = 0; n < 7; ++n) { const bool ok = (n < uq) && !((sel >> n) & 1u) && (g[n] > best); best = ok ? g[n] : best; bi = ok ? n : bi; }
                if (bi >= 0) sel |= 1u << bi; }
        } else sel = (1u << uq) - 1u;
        sel |= 1u << uq;
    }
    if constexpr (VAR == 1) {
        LAS float* cs = (LAS float*)(lds + L_AUX); LAS float* wt = (LAS float*)(lds + L_WS);
        f32x4 v = lfv;
        v[1] += v[0]; v[2] += v[1]; v[3] += v[2];
        float incl = v[3];
#pragma unroll
        for (int o = 1; o < 64; o <<= 1) { const float u = __shfl_up(incl, o); if (lane >= o) incl += u; }
        if (lane == 63) wt[wid] = incl;
        __syncthreads();
        float woff = 0.f;
#pragma unroll
        for (int w = 0; w < 8; ++w) woff += (w < wid) ? wt[w] : 0.f;
        const float ex = incl - v[3] + woff;
        *(LAS f32x4*)(cs + 4 * tid) = (f32x4){(ex + v[0]) * LOG2E, (ex + v[1]) * LOG2E, (ex + v[2]) * LOG2E, (ex + v[3]) * LOG2E};
        __syncthreads();
        cst = cs[t] - M0;
    }
    const float TH = 2.0f * M0 + 27.0f;
    float THw = TH;
    bool have_m = false;
    int t_first = t_lo; float dmax = 1e30f; float cs_wmin = 0.f;
    if constexpr (VAR == 0 || VAR == 2) {
        dmax = TH / slope2;
        const int t_umin = (VAR == 0) ? uq * 256 : uq * 128;
        const float f = ((float)t_umin - dmax - 63.0f) * (1.0f / 64.0f);
        if (f > (float)t_lo) { const int c = (int)ceilf(f); t_first = c < t_hi - 1 ? c : t_hi - 1; }
    }
    if constexpr (VAR == 1) {
        const LAS float* cs = (const LAS float*)(lds + L_AUX);
        const float cu = cs[uq * 256];
        { const int ti_ = lane & 31; const bool keep_ = (ti_ >= t_hi - 1) || ((cu - cs[ti_ * 64 + 63]) >= -TH);
          t_first = __builtin_amdgcn_readfirstlane(__builtin_ctzll(__ballot(keep_) | (1ull << 31))); }
        cs_wmin = cs[twmin];
    }
    int tw_first = 0;
#define FOX_FIRST() do { if constexpr (VAR == 1) { const int ti_ = lane & 31; const bool keep_ = (ti_ * 64 + 63 >= twmin) || ((cs_wmin - ((const LAS float*)(lds + L_AUX))[ti_ * 64 + 63]) >= -THw); \
        const unsigned long long bm_ = __ballot(keep_); tw_first = __builtin_amdgcn_readfirstlane(__builtin_ctzll(bm_ | (1ull << 31))); } } while (0)
    FOX_FIRST();
    const int n = t_hi - t_first;
    unsigned kro[4];
#pragma unroll
    for (int d0 = 0; d0 < 4; ++d0) { const int ch = 2 * d0 + hi; kro[d0] = lds0 + ((VAR == 2) ? (wid & 1) * 8192 : 0) + r32 * 128 + ((ch ^ ((r32 >> 1) & 7)) << 4); }
    const unsigned vro = lds0 + KTB + ((lane >> 4) & 1) * 32 + (lane & 3) * 8 + (4 * hi + ((lane & 15) >> 2)) * 64;
    f32x16 o[NDB];
#pragma unroll
    for (int db = 0; db < NDB; ++db) o[db] = (f32x16){};
    float lsum = 0.f;
#define ACT(tt, out) do { const int kv0_ = (tt) * 64; bool a_ = kv0_ <= twmax; \
        if constexpr (VAR == 0 || VAR == 2) a_ = a_ && ((float)(twmin - (kv0_ + 63)) * slope2 <= THw); \
        if constexpr (VAR == 1) a_ = a_ && ((tt) >= tw_first); \
        out = a_; } while (0)
#define QK_STEP(tt, kb, P0, P1) do { const int kv0_ = (tt) * 64; bf16x8 kf[8]; \
        _Pragma("unroll") for (int d0 = 0; d0 < 4; ++d0) { kf[2 * d0] = *(const LAS bf16x8*)(kro[d0] + (kb) * SLOT); kf[2 * d0 + 1] = *(const LAS bf16x8*)(kro[d0] + (kb) * SLOT + 4096); } \
        if constexpr (VAR == 1) { const LAS float* cs_ = (const LAS float*)(lds + L_AUX) + kv0_ + 4 * hi; f32x4 c0[4], c1[4]; \
            _Pragma("unroll") for (int g4 = 0; g4 < 4; ++g4) { c0[g4] = *(const LAS f32x4*)(cs_ + 8 * g4); c1[g4] = *(const LAS f32x4*)(cs_ + 32 + 8 * g4); } \
            __builtin_amdgcn_sched_barrier(0);        \
            _Pragma("unroll") for (int g4 = 0; g4 < 4; ++g4) { _Pragma("unroll") for (int e = 0; e < 4; ++e) { P0[4 * g4 + e] = cst - c0[g4][e]; P1[4 * g4 + e] = cst - c1[g4][e]; } } \
        } else { __builtin_amdgcn_sched_barrier(0); float base = slope2 * (float)(kv0_ + 4 * hi - t) - M0; \
            if constexpr (VAR == 0) { if (!((sel >> ((tt) >> 2)) & 1u)) base = -1e30f; } \
            _Pragma("unroll") for (int r = 0; r < 16; ++r) { P0[r] = fmaf(slope2, (float)(8 * (r >> 2) + (r & 3)), base); P1[r] = fmaf(slope2, (float)(32 + 8 * (r >> 2) + (r & 3)), base); } } \
        _Pragma("unroll") for (int d0 = 0; d0 < 4; ++d0) { P0 = __builtin_amdgcn_mfma_f32_32x32x16_bf16(kf[2 * d0], qr[d0], P0, 0, 0, 0); P1 = __builtin_amdgcn_mfma_f32_32x32x16_bf16(kf[2 * d0 + 1], qr[d0], P1, 0, 0, 0); } \
    } while (0)
#define SM_STEP(tt, vb, P0, P1) do { const int kv0_ = (tt) * 64; \
        if (kv0_ + 63 > twmin) { _Pragma("unroll") for (int r = 0; r < 16; ++r) { const int kv = kv0_ + crow(r, hi); if (kv > t) P0[r] = -INFINITY; if (kv + 32 > t) P1[r] = -INFINITY; } } \
        if constexpr (VAR == 3) { if (kv0_ <= twmax - 128) { _Pragma("unroll") for (int r = 0; r < 16; ++r) { const int kv = kv0_ + crow(r, hi); if (kv <= t - 128) P0[r] = -INFINITY; if (kv + 32 <= t - 128) P1[r] = -INFINITY; } } } \
        if constexpr (VAR != 3) { if (!have_m) { float m_ = fmaxf(P0[0], P1[0]); _Pragma("unroll") for (int r = 1; r < 16; ++r) m_ = fmaxf(m_, fmaxf(P0[r], P1[r])); \
            m_ = xmax32(m_); m_ = rmin16(m_); m_ = xmin16(m_); \
            if (m_ > -1e20f) { THw = fminf(THw, 27.0f - m_); have_m = true; FOX_FIRST(); } } } \
          \
        float lacc_ = 0.f; u32x4 pwc_, pwn_ = (u32x4){0u, 0u, 0u, 0u}; s16x4 vl[NDB], vh[NDB]; \
        _Pragma("unroll") for (int e_ = 0; e_ < 8; ++e_) { P0[e_] = __builtin_amdgcn_exp2f(P0[e_]); lacc_ += P0[e_]; } \
        pwc_ = (u32x4){pk_bf16(P0[0], P0[1]), pk_bf16(P0[2], P0[3]), pk_bf16(P0[4], P0[5]), pk_bf16(P0[6], P0[7])}; \
        _Pragma("unroll") for (int ks_ = 0; ks_ < 4; ++ks_) { \
            _Pragma("unroll") for (int db = 0; db < NDB; ++db) { vl[db] = vtr(vro + (vb) * SLOT + db * 4096 + ks_ * 1024); vh[db] = vtr(vro + (vb) * SLOT + db * 4096 + ks_ * 1024 + 512); } \
            _Pragma("unroll") for (int db = 0; db < NDB; ++db) { \
                const bf16x8 vf = (bf16x8){vl[db][0], vl[db][1], vl[db][2], vl[db][3], vh[db][0], vh[db][1], vh[db][2], vh[db][3]}; \
                o[db] = __builtin_amdgcn_mfma_f32_32x32x16_bf16(__builtin_bit_cast(bf16x8, pwc_), vf, o[db], 0, 0, 0); \
                if (ks_ < 3) { constexpr int EPG = 8 / NDB;   \
                    _Pragma("unroll") for (int j_ = 0; j_ < EPG; ++j_) { const int e_ = 8 * ((ks_ + 1) & 1) + db * EPG + j_; \
                        if (ks_ + 1 < 2) { P0[e_] = __builtin_amdgcn_exp2f(P0[e_]); lacc_ += P0[e_]; } else { P1[e_] = __builtin_amdgcn_exp2f(P1[e_]); lacc_ += P1[e_]; } } \
                    if (EPG == 2) { const int e_ = 8 * ((ks_ + 1) & 1) + db * 2; pwn_[db] = (ks_ + 1 < 2) ? pk_bf16(P0[e_], P0[e_ + 1]) : pk_bf16(P1[e_], P1[e_ + 1]); } \
                    else { const int e_ = 8 * ((ks_ + 1) & 1) + db * 4; pwn_[2 * db] = (ks_ + 1 < 2) ? pk_bf16(P0[e_], P0[e_ + 1]) : pk_bf16(P1[e_], P1[e_ + 1]); pwn_[2 * db + 1] = (ks_ + 1 < 2) ? pk_bf16(P0[e_ + 2], P0[e_ + 3]) : pk_bf16(P1[e_ + 2], P1[e_ + 3]); } \
                    asm volatile("" : "+v"(lacc_), "+v"(pwn_)); } \
                __builtin_amdgcn_sched_barrier(0); } \
            pwc_ = pwn_; } \
        lsum += lacc_; \
    } while (0)
#define WAITBAR(N) asm volatile("s_waitcnt vmcnt(" #N ") lgkmcnt(0)\n\ts_barrier" ::: "memory")
#define ITER(ii, PA0, PA1, PB0, PB1) do { const int it_ = (ii), tt_ = n_hi - it_, bcur_ = sc, bnxt_ = (sc + 1 == NS) ? 0 : sc + 1; bool a0_, a1_ = false; ACT(tt_, a0_); \
        DMA_TILE(it_ + DPF, (sc == 0) ? NS - 1 : sc - 1); sc = bnxt_; \
        (void)a1_; (void)bnxt_; if (a0_) { QK_STEP(tt_, bcur_, PA0, PA1); SM_STEP(tt_, bcur_, PA0, PA1); } \
        if constexpr (NP == 2) WAITBAR(4); else WAITBAR(2); } while (0)
#define SB() __builtin_amdgcn_sched_barrier(0)
#define KLOAD2(d0, sl) do { kf[2 * (d0)] = *(const LAS bf16x8*)(kro[d0] + (sl) * SLOT); kf[2 * (d0) + 1] = *(const LAS bf16x8*)(kro[d0] + (sl) * SLOT + 4096); } while (0)
#define CINIT(tt, C0, C1) do { const int kv0_ = (tt) * 64; \
        if constexpr (VAR == 1) { const LAS float* cs_ = (const LAS float*)(lds + L_AUX) + kv0_ + 4 * hi; f32x4 c0[4], c1[4];        \
            _Pragma("unroll") for (int g4 = 0; g4 < 4; ++g4) { c0[g4] = *(const LAS f32x4*)(cs_ + 8 * g4); c1[g4] = *(const LAS f32x4*)(cs_ + 32 + 8 * g4); } \
            SB(); \
            _Pragma("unroll") for (int g4 = 0; g4 < 4; ++g4) { _Pragma("unroll") for (int e = 0; e < 4; ++e) { C0[4 * g4 + e] = cst - c0[g4][e]; C1[4 * g4 + e] = cst - c1[g4][e]; } } \
        } else { float base = slope2 * (float)(kv0_ + 4 * hi - t) - M0; \
            if constexpr (VAR == 0) { if (!((sel >> ((tt) >> 2)) & 1u)) base = -1e30f; } \
            _Pragma("unroll") for (int r = 0; r < 16; ++r) { C0[r] = fmaf(slope2, (float)(8 * (r >> 2) + (r & 3)), base); C1[r] = fmaf(slope2, (float)(32 + 8 * (r >> 2) + (r & 3)), base); } } } while (0)
#define MASKM(tt, C0, C1) do { const int kv0_ = (tt) * 64; \
        if (kv0_ + 63 > twmin) { _Pragma("unroll") for (int r = 0; r < 16; ++r) { const int kv = kv0_ + crow(r, hi); if (kv > t) C0[r] = -INFINITY; if (kv + 32 > t) C1[r] = -INFINITY; } } \
        if constexpr (VAR == 3) { if (kv0_ <= twmax - 128) { _Pragma("unroll") for (int r = 0; r < 16; ++r) { const int kv = kv0_ + crow(r, hi); if (kv <= t - 128) C0[r] = -INFINITY; if (kv + 32 <= t - 128) C1[r] = -INFINITY; } } } \
        if constexpr (VAR != 3) { if (!have_m) { float m_ = fmaxf(C0[0], C1[0]); _Pragma("unroll") for (int r = 1; r < 16; ++r) m_ = fmaxf(m_, fmaxf(C0[r], C1[r])); \
            m_ = xmax32(m_); m_ = rmin16(m_); m_ = xmin16(m_); \
            if (m_ > -1e20f) { THw = fminf(THw, 27.0f - m_); have_m = true; FOX_FIRST(); } } } } while (0)
#define VRD(i, sl) do { vl[(i) & 3] = vtr(vro + (sl) * SLOT + ((i) >> 2) * 4096 + ((i) & 3) * 1024); vh[(i) & 3] = vtr(vro + (sl) * SLOT + ((i) >> 2) * 4096 + ((i) & 3) * 1024 + 512); } while (0)
#define VFR(i) ((bf16x8){vl[(i) & 3][0], vl[(i) & 3][1], vl[(i) & 3][2], vl[(i) & 3][3], vh[(i) & 3][0], vh[(i) & 3][1], vh[(i) & 3][2], vh[(i) & 3][3]})
#define PEL(P0, P1, k, j) (((k) < 4) ? P0[4 * ((k) & 3) + (j)] : P1[4 * ((k) & 3) + (j)])
#define QKM(k, C0, C1) do { if (((k) & 1) == 0) C0 = __builtin_amdgcn_mfma_f32_32x32x16_bf16(kf[k], qr[(k) >> 1], C0, 0, 0, 0); else C1 = __builtin_amdgcn_mfma_f32_32x32x16_bf16(kf[k], qr[(k) >> 1], C1, 0, 0, 0); } while (0)
#define SUMCVT4(k, P0, P1) do { lacc += PEL(P0, P1, k, 0); lacc += PEL(P0, P1, k, 1); lacc += PEL(P0, P1, k, 2); lacc += PEL(P0, P1, k, 3); \
        pw[(k) >> 1][((k) & 1) * 2] = pk_bf16(PEL(P0, P1, k, 0), PEL(P0, P1, k, 1)); pw[(k) >> 1][((k) & 1) * 2 + 1] = pk_bf16(PEL(P0, P1, k, 2), PEL(P0, P1, k, 3)); } while (0)
#define EXP4(k, C0, C1) do { _Pragma("unroll") for (int j_ = 0; j_ < 4; ++j_) { if ((k) < 4) C0[4 * ((k) & 3) + j_] = __builtin_amdgcn_exp2f(C0[4 * ((k) & 3) + j_]); else C1[4 * ((k) & 3) + j_] = __builtin_amdgcn_exp2f(C1[4 * ((k) & 3) + j_]); } } while (0)
#define PVM(k) do { o[(k) >> 2] = __builtin_amdgcn_mfma_f32_32x32x16_bf16(__builtin_bit_cast(bf16x8, pw[(k) & 3]), VFR(k), o[(k) >> 2], 0, 0, 0); } while (0)
#define PINV(x) asm volatile("" : "+v"(x))
#define GAPA(k, C0, C1, P0, P1, slv) do { if ((k) >= 4) VRD((k) - 4, slv); QKM(k, C0, C1); SUMCVT4(k, P0, P1); PINV(lacc); PINV(pw[(k) >> 1]); SB(); } while (0)
#define GAPB(k, C0, C1, slk, slv, dok) do { if ((k) >= 2 && (k) <= 5) KLOAD2((k) - 2, slk); PVM(k); if ((k) < 4) VRD((k) + 4, slv); EXP4(k, C0, C1); if ((k) < 4) PINV(C0); else PINV(C1); SB(); } while (0)
#define STEP(tstep, C0, C1, Pp0, Pp1) do { const int ts_ = (tstep), tt_ = n_hi - ts_; const int slc_ = sc, slp_ = (sc == 0) ? NS - 1 : sc - 1, sln_ = (sc + 1 == NS) ? 0 : sc + 1; \
        DMA_TILE(ts_ + DPF, (slp_ == 0) ? NS - 1 : slp_ - 1); sc = sln_; \
        bool a_next = false; if (ts_ + 1 < n) ACT(tt_ - 1, a_next); \
        const bool a_c = (ts_ < n) && a_cur; \
        if (a_c && a_prev) { \
            float lacc = 0.f; s16x4 vl[4], vh[4]; \
            CINIT(tt_, C0, C1); SB(); \
            GAPA(0, C0, C1, Pp0, Pp1, slp_); GAPA(1, C0, C1, Pp0, Pp1, slp_); GAPA(2, C0, C1, Pp0, Pp1, slp_); GAPA(3, C0, C1, Pp0, Pp1, slp_); \
            GAPA(4, C0, C1, Pp0, Pp1, slp_); GAPA(5, C0, C1, Pp0, Pp1, slp_); GAPA(6, C0, C1, Pp0, Pp1, slp_); GAPA(7, C0, C1, Pp0, Pp1, slp_); \
            lsum += lacc; MASKM(tt_, C0, C1); SB(); \
            GAPB(0, C0, C1, sln_, slp_, a_next); GAPB(1, C0, C1, sln_, slp_, a_next); GAPB(2, C0, C1, sln_, slp_, a_next); GAPB(3, C0, C1, sln_, slp_, a_next); \
            GAPB(4, C0, C1, sln_, slp_, a_next); GAPB(5, C0, C1, sln_, slp_, a_next); GAPB(6, C0, C1, sln_, slp_, a_next); GAPB(7, C0, C1, sln_, slp_, a_next); \
        } else { \
            if (a_c) { CINIT(tt_, C0, C1); SB(); _Pragma("unroll") for (int k_ = 0; k_ < 8; k_ += 2) { C0 = __builtin_amdgcn_mfma_f32_32x32x16_bf16(kf[k_], qr[k_ >> 1], C0, 0, 0, 0); C1 = __builtin_amdgcn_mfma_f32_32x32x16_bf16(kf[k_ + 1], qr[k_ >> 1], C1, 0, 0, 0); } } \
            if (a_prev) { float lacc = 0.f; s16x4 vl[4], vh[4]; VRD(0, slp_); VRD(1, slp_); VRD(2, slp_); VRD(3, slp_); \
                SUMCVT4(0, Pp0, Pp1); SUMCVT4(1, Pp0, Pp1); SUMCVT4(2, Pp0, Pp1); SUMCVT4(3, Pp0, Pp1); SUMCVT4(4, Pp0, Pp1); SUMCVT4(5, Pp0, Pp1); SUMCVT4(6, Pp0, Pp1); SUMCVT4(7, Pp0, Pp1); lsum += lacc; \
                PVM(0); PVM(1); PVM(2); PVM(3); VRD(4, slp_); VRD(5, slp_); VRD(6, slp_); VRD(7, slp_); PVM(4); PVM(5); PVM(6); PVM(7); } \
            if (a_c) { MASKM(tt_, C0, C1); EXP4(0, C0, C1); EXP4(1, C0, C1); EXP4(2, C0, C1); EXP4(3, C0, C1); EXP4(4, C0, C1); EXP4(5, C0, C1); EXP4(6, C0, C1); EXP4(7, C0, C1); } \
            if (a_next) { KLOAD2(0, sln_); KLOAD2(1, sln_); KLOAD2(2, sln_); KLOAD2(3, sln_); } \
        } \
        a_prev = a_c; a_cur = a_next; \
        asm volatile("s_waitcnt vmcnt(5) lgkmcnt(0)\n\ts_barrier" ::: "memory"); } while (0)
    asm volatile("" : "+v"(qr[0]), "+v"(qr[1]), "+v"(qr[2]), "+v"(qr[3]));
    asm volatile("s_waitcnt vmcnt(0) lgkmcnt(0)\n\ts_barrier" ::: "memory");
    if constexpr (PIPE) { DMA_TILE(2, 2); DMA_TILE(3, 3); }
    if (VAR != 2 || !(wid & 1)) { constexpr int CPR = DV / 8, NG = 32 * CPR / 64;
#pragma unroll
        for (int i = 0; i < NG; ++i) { const int idx = i * 64 + lane, row = idx / CPR, ch = idx % CPR;
            glds16(proj + HM(rowb + wq0 + row, colG + ch * 8), (unsigned)__builtin_amdgcn_readfirstlane((int)(gbase + i * 1024))); } }
    f32x16 pa0, pa1, pb0, pb1; int sc = 0;
    if constexpr (PIPE) {
        bf16x8 kf[8]; u32x4 pw[4]; bool a_prev = false, a_cur;
        ACT(n_hi, a_cur);
        if (a_cur) { KLOAD2(0, 0); KLOAD2(1, 0); KLOAD2(2, 0); KLOAD2(3, 0); }
        for (int ts = 0; ts <= n; ts += 2) {
            STEP(ts, pa0, pa1, pb0, pb1);
            if (ts + 1 <= n) STEP(ts + 1, pb0, pb1, pa0, pa1);
        }
    } else {
        for (int i = 0; i < n; ++i) ITER(i, pa0, pa1, pb0, pb1);
    }
    asm volatile("s_waitcnt vmcnt(0) lgkmcnt(0)\n\ts_barrier" ::: "memory");
#undef DMA_TILE
#undef WAITBAR
#undef FOX_FIRST
#undef ACT
#undef QK_STEP
#undef SM_STEP
#undef ITER
#undef STEP
#undef GAPA
#undef PINV
#undef GAPB
#undef PVM
#undef EXP4
#undef SUMCVT4
#undef QKM
#undef PEL
#undef VFR
#undef VRD
#undef MASKM
#undef CINIT
#undef KLOAD2
#undef SB
    lsum = xadd32(lsum);
    if constexpr (VAR == 3) lsum += exp2f(sinkv * LOG2E - M0);
    LAS float* wsf = (LAS float*)(lds + L_WS) + wid * 64;
    if (hi == 0) wsf[r32] = 1.0f / lsum;
    asm volatile("s_waitcnt lgkmcnt(0)" ::: "memory");
    float rli[16];
#pragma unroll
    for (int r = 0; r < 16; ++r) rli[r] = wsf[crow(r, hi)];
#define OUT_ROWS(ost, NCH) do { asm volatile("s_waitcnt lgkmcnt(0)" ::: "memory"); \
        _Pragma("unroll") for (int i_ = 0; i_ < 32 * (NCH) / 64; ++i_) { const int idx_ = i_ * 64 + lane, row_ = idx_ / (NCH), ch_ = idx_ % (NCH); \
            const f32x4 a_ = *(const LAS f32x4*)((ost) + row_ * DV + ch_ * 8), b_ = *(const LAS f32x4*)((ost) + row_ * DV + ch_ * 8 + 4); \
            const u32x4 g_ = *(const LAS u32x4*)(gbase + row_ * GP + ch_ * 16); u32x4 w_; \
            w_.x = pk_bf16(a_[0] * __uint_as_float(g_.x << 16), a_[1] * __uint_as_float(g_.x & 0xffff0000u)); w_.y = pk_bf16(a_[2] * __uint_as_float(g_.y << 16), a_[3] * __uint_as_float(g_.y & 0xffff0000u)); \
            w_.z = pk_bf16(b_[0] * __uint_as_float(g_.z << 16), b_[1] * __uint_as_float(g_.z & 0xffff0000u)); w_.w = pk_bf16(b_[2] * __uint_as_float(g_.w << 16), b_[3] * __uint_as_float(g_.w & 0xffff0000u)); \
            *(u32x4*)(Y + (rowb + wq0 + row_) * DM + colY + ch_ * 8) = w_; } } while (0)
    if constexpr (VAR != 2) {
        LAS float* ost = (LAS float*)lds + wid * 2048;
#pragma unroll
        for (int r = 0; r < 16; ++r)
#pragma unroll
            for (int db = 0; db < NDB; ++db) ost[crow(r, hi) * DV + db * 32 + r32] = o[db][r] * rli[r];
        OUT_ROWS(ost, 8);
        __syncthreads();
    } else {
        int ljo = lj; asm volatile("" : "+s"(ljo));
        const float* lp = P->diff_lambda + ljo * 256; const int layer = 2 * ljo + 1;
        const float lam_init = 0.8f - 0.6f * expf(-0.3f * (float)layer);
        const float lam = expf(wave_sum(lp[lane] * lp[64 + lane])) - expf(wave_sum(lp[128 + lane] * lp[192 + lane])) + lam_init;
        LAS float* ex = (LAS float*)lds + (wid >> 1) * 4096;
        if (wid & 1) {
#pragma unroll
            for (int db = 0; db < NDB; ++db)
#pragma unroll
                for (int r = 0; r < 16; ++r) ex[(db * 16 + r) * 64 + lane] = o[db][r] * rli[r];
        }
        __syncthreads();
        if (!(wid & 1)) {
            float ss[16];
#pragma unroll
            for (int r = 0; r < 16; ++r) { float a = 0.f;
#pragma unroll
                for (int db = 0; db < NDB; ++db) { const float v = o[db][r] * rli[r] - lam * ex[(db * 16 + r) * 64 + lane]; o[db][r] = v; a += v * v; }
                a = rsum16(a); a = xadd16(a);
                ss[r] = __builtin_amdgcn_rsqf(a * (1.0f / 128.0f) + EPS) * (1.0f - lam_init); }
            float sg[NDB];
#pragma unroll
            for (int db = 0; db < NDB; ++db) sg[db] = P->diff_subln_gain[lj * 128 + db * 32 + r32];
            asm volatile("s_waitcnt lgkmcnt(0)" ::: "memory");
            LAS float* ost = ex;
#pragma unroll
            for (int r = 0; r < 16; ++r)
#pragma unroll
                for (int db = 0; db < NDB; ++db) ost[crow(r, hi) * DV + db * 32 + r32] = o[db][r] * ss[r] * sg[db];
            OUT_ROWS(ost, 16);
        }
        __syncthreads();
    }
#undef OUT_ROWS
}

__device__ __forceinline__ void phase_attn(CP P, int layer, ldsp lds, unsigned* ctr) {
    const int tid = opaque_tid(); const int lj = layer >> 1;
    volatile LAS unsigned* qw = (volatile LAS unsigned*)(lds + LDS_QW);
    const unsigned G = gridDim.x;
    unsigned nxt = blockIdx.x;
    if (tid == 0) qw[8] = 0u;
    for (;;) {
        if (tid == 0) *qw = nxt;
        __syncthreads();
        const unsigned u = *qw;
        __syncthreads();
        unsigned ua = u;
        if (layer == 0) {
            if (u >= 2048u + CONV_TICKETS) break;
            if (u < 9u * CONV_TICKETS) { if (u % 9u == 8u) ua = 0xffffffffu; else ua = u - (u + 1u) / 9u; } else ua = u - CONV_TICKETS;
        } else if (u >= 2048u) break;
        const bool pre = true;
        if (pre && tid == 0) nxt = atomicAdd(ctr, 1u) + G;
        if (ua == 0xffffffffu) {
            const int tc = opaque_tid(), lane = tc & 63, wid = __builtin_amdgcn_readfirstlane(tc >> 6); LAS float* scr = (LAS float*)(lds + wid * 16384);
            CP Pc = P; asm volatile("" : "+s"(Pc));
            const int it0 = I_AB + __builtin_amdgcn_readfirstlane((int)(u / 9u)) * 32 + wid * 4;
#pragma nounroll
            for (int j = 0; j < 4; ++j) convert_item(Pc, it0 + j, scr, lane);
        } else if (!(layer & 1)) { const int qb = 7 - (int)(ua >> 8), r = ua & 255, kind = r >> 7, b = (r >> 3) & 15, h = r & 7;
            if (kind == 0) { if (EN & 16) attn_unit<0>(P, lj, b, h, qb, lds); } else { if (EN & 32) attn_unit<1>(P, lj, b, h, qb, lds); } }
        else { if (u < 1024u) { const int qb = 15 - (int)(u >> 6), r = u & 63; if (EN & 64) attn_unit<2>(P, lj, r >> 2, r & 3, qb, lds); }
            else { if (qw[8] == 0u) {
                    if (tid == 0) { unsigned sp_ = 0; while (__hip_atomic_load(ctr + 32, __ATOMIC_RELAXED, __HIP_MEMORY_SCOPE_AGENT) < (unsigned)(MTOK / 256)) { __builtin_amdgcn_s_sleep(2); if (++sp_ > (1u << 22)) break; }
                        __builtin_amdgcn_fence(__ATOMIC_ACQUIRE, "agent"); asm volatile("s_waitcnt vmcnt(0)" ::: "memory"); }
                    __syncthreads(); if (tid == 0) qw[8] = 1u; }
              const unsigned v = u - 1024u; const int qb = 31 - (int)(v >> 5), r = v & 31; if (EN & 128) attn_unit<3>(P, lj, r >> 1, r & 1, qb, lds); } }
        if (!pre && tid == 0) nxt = atomicAdd(ctr, 1u) + G;
    }
}

#define XB_TMO      128
#define XB_XCNT(j)  (256  + 64 * (j))
#define XB_XSUB(j)  (1280 + 64 * (j))
#define XB_XGEN(j)  (2304 + 64 * (j))
#define XB_TOP      3328
#define XB_TOPGEN   3392
#define XCD_BAR_WORDS 3456
#define XB_SPIN_CAP (1u << 18)

__device__ __forceinline__ unsigned xb_ld(unsigned* p)              { return __hip_atomic_load(p, __ATOMIC_RELAXED, __HIP_MEMORY_SCOPE_AGENT); }
__device__ __forceinline__ unsigned xb_add(unsigned* p, unsigned v) { return __hip_atomic_fetch_add(p, v, __ATOMIC_RELAXED, __HIP_MEMORY_SCOPE_AGENT); }
__device__ __forceinline__ unsigned xb_xcc_id() { return (unsigned)__builtin_amdgcn_s_getreg((3 << 11) | 20) & 0xFu; }
#define XB_SPIN(cond, bar) do { unsigned _sp = 0; while (cond) { __builtin_amdgcn_s_sleep(1); \
    if ((++_sp & 255u) == 0u) { if (xb_ld(&(bar)[XB_TMO])) break; if (_sp > XB_SPIN_CAP) { atomicAdd(&(bar)[XB_TMO], 1u); break; } } } } while (0)

struct XcdBarrier {
    unsigned* bar; unsigned x;
    volatile LAS unsigned* st;
};

__device__ __forceinline__ XcdBarrier xcd_barrier_post(unsigned* bar, volatile LAS unsigned* st) {
    XcdBarrier b; b.bar = bar; b.x = xb_xcc_id(); b.st = st;
    if (threadIdx.x == 0) (void)xb_add(&bar[XB_XCNT(b.x)], 1u);
    return b;
}
__device__ __forceinline__ void xcd_barrier_complete(unsigned* bar, unsigned x, unsigned& nloc, unsigned& nx) {
    const unsigned G = gridDim.x * gridDim.y * gridDim.z;
    unsigned sum, cnt, mine, sp = 0u;
    for (;;) {
        sum = 0u; cnt = 0u; mine = 0u;
        unsigned cj[16]; { const unsigned* mid = &bar[XB_XCNT(8)];
          asm volatile("global_load_dword %0, %16, off offset:-2048 sc1\n\tglobal_load_dword %1, %16, off offset:-1792 sc1\n\tglobal_load_dword %2, %16, off offset:-1536 sc1\n\tglobal_load_dword %3, %16, off offset:-1280 sc1\n\t"
                       "global_load_dword %4, %16, off offset:-1024 sc1\n\tglobal_load_dword %5, %16, off offset:-768 sc1\n\tglobal_load_dword %6, %16, off offset:-512 sc1\n\tglobal_load_dword %7, %16, off offset:-256 sc1\n\t"
                       "global_load_dword %8, %16, off sc1\n\tglobal_load_dword %9, %16, off offset:256 sc1\n\tglobal_load_dword %10, %16, off offset:512 sc1\n\tglobal_load_dword %11, %16, off offset:768 sc1\n\t"
                       "global_load_dword %12, %16, off offset:1024 sc1\n\tglobal_load_dword %13, %16, off offset:1280 sc1\n\tglobal_load_dword %14, %16, off offset:1536 sc1\n\tglobal_load_dword %15, %16, off offset:1792 sc1\n\t"
                       "s_waitcnt vmcnt(0)"
                       : "=&v"(cj[0]), "=&v"(cj[1]), "=&v"(cj[2]), "=&v"(cj[3]), "=&v"(cj[4]), "=&v"(cj[5]), "=&v"(cj[6]), "=&v"(cj[7]),
                         "=&v"(cj[8]), "=&v"(cj[9]), "=&v"(cj[10]), "=&v"(cj[11]), "=&v"(cj[12]), "=&v"(cj[13]), "=&v"(cj[14]), "=&v"(cj[15])
                       : "v"(mid) : "memory"); }
#pragma unroll
        for (unsigned j = 0; j < 16; ++j) { const unsigned c = cj[j]; sum += c; cnt += (c > 0u) ? 1u : 0u; mine = (j == x) ? c : mine; }
        if (sum == G) break;
        __builtin_amdgcn_s_sleep(1);
        if ((++sp & 255u) == 0u) { if (xb_ld(&bar[XB_TMO])) break; if (sp > XB_SPIN_CAP) { atomicAdd(&bar[XB_TMO], 1u); break; } }
    }
    nloc = mine > 0u ? mine : 1u; nx = cnt > 0u ? cnt : 1u;
}

__device__ __forceinline__ void xcd_barrier(const XcdBarrier& b) {
    asm volatile("s_waitcnt vmcnt(0)" ::: "memory");
    __syncthreads();
    if (threadIdx.x == 0) {
        unsigned* bar = b.bar;
        __builtin_amdgcn_s_waitcnt(0);
        unsigned nloc = b.st[0], nx = b.st[1];
        if (nloc == 0u) { xcd_barrier_complete(bar, b.x, nloc, nx); b.st[0] = nloc; b.st[1] = nx; }
        const unsigned old = xb_add(&bar[XB_XSUB(b.x)], 1u);
        const unsigned gen = old / nloc;
        if (old + 1u == (gen + 1u) * nloc) {
            __builtin_amdgcn_fence(__ATOMIC_RELEASE, "agent");
            asm volatile("s_waitcnt vmcnt(0)" ::: "memory");
            const unsigned og = xb_add(&bar[XB_TOP], 1u);
            const unsigned tg = og / nx;
            if (og + 1u == (tg + 1u) * nx) xb_add(&bar[XB_TOPGEN], 1u);
            else XB_SPIN(xb_ld(&bar[XB_TOPGEN]) == tg, bar);
            __builtin_amdgcn_fence(__ATOMIC_ACQUIRE, "agent");
            xb_add(&bar[XB_XGEN(b.x)], 1u);
            asm volatile("s_waitcnt vmcnt(0)" ::: "memory");
        } else {
            XB_SPIN(xb_ld(&bar[XB_XGEN(b.x)]) == gen, bar);
            __builtin_amdgcn_fence(__ATOMIC_ACQUIRE, "agent");
            asm volatile("s_waitcnt vmcnt(0)" ::: "memory");
        }
    }
    __syncthreads();
}


#ifndef MK_N_LAUNCHES
#define MK_N_LAUNCHES 1
#endif
__global__ void __launch_bounds__(512, 2) mega_fwd(Params Pv) {
    CP P = (CP)__builtin_amdgcn_kernarg_segment_ptr(); (void)Pv;
    extern __shared__ __attribute__((aligned(16))) unsigned char lds_raw[];
    ldsp lds = (ldsp)lds_raw;
    cg::grid_group grid = cg::this_grid();
    unsigned* ctl = (unsigned*)(P->ws + WS_CTL);
    volatile LAS unsigned* bst = (volatile LAS unsigned*)(lds + LDS_QW + 16);
    if (threadIdx.x < 2) bst[threadIdx.x] = 0u;
    __syncthreads();
#if MK_N_LAUNCHES == 1
    for (unsigned i = blockIdx.x * 512u + threadIdx.x; i < CTL_ZERO_BYTES / 4; i += gridDim.x * 512u) ctl[i] = 0u;
    grid.sync();
#endif
    XcdBarrier bar = xcd_barrier_post(ctl + 4096, bst);
    const int ph_lo = P->ph_lo, ph_hi = P->ph_hi;
    for (int ph = ph_lo; ph < ph_hi; ++ph) {
        asm volatile("" : "+s"(P));
        if (ph == 0) { if (EN & 1) phase_prologue(P, lds); }
        else {
            const int layer = (ph - 1) / 3, sub = (ph - 1) % 3, lj = layer >> 1, cd = layer & 1;
            if (sub == 0 || (sub == 1 && cd)) {
                pg8::Gemm g{(const bf16_t*)(P->ws + WS_XB), cd ? (const bf16_t*)(P->ws + WS_WT_CD) + (size_t)lj * CD_N * 1024 : (const bf16_t*)(P->ws + WS_WT_AB) + (size_t)lj * AB_N * 1024, MTOK, cd ? CD_N : AB_N, DM};
                pg8::StaticOrder S; if (sub == 0) S.init(MTOK, cd ? CD_N - 256 : AB_N, (int)gridDim.x, (int)blockIdx.x); else S.init_tail(MTOK, CD_N / 256 - 1, (int)gridDim.x, (int)blockIdx.x);
                pg8::EpiIn E{(bf16_t*)(P->ws + WS_PROJ), cd ? CD_N : AB_N, (const float*)(P->ws + WS_SSQ), cd,
                             cd ? P->diff_q_gain + lj * 64 : P->moba_q_gain + lj * 64, cd ? P->diff_k_gain + lj * 64 : P->moba_k_gain + lj * 64,
                             cd ? P->swa_q_gain + lj * 64 : P->fox_q_gain + lj * 64, cd ? P->swa_k_gain + lj * 64 : P->fox_k_gain + lj * 64,
                             (float*)(P->ws + WS_KMEAN), (LAS float*)(lds + LDS_MISC)};
                { const int t = opaque_tid();
                  if (t < 256) { const float* gp = t < 64 ? E.gq0 : t < 128 ? E.gk0 : t < 192 ? E.gq1 : E.gk1; ((LAS float*)(lds + LDS_MISC + 8192))[t] = gp[t & 63]; }
                  __syncthreads(); }
                if (EN & 2) pg8::gemm_phase<pg8::EpiIn, pg8::StaticOrder, true, true>(lds, g, S, E);
                if (sub == 0) { if (EN & 4) if (!cd) fgate_pass(P, lj, lds); }
                else {
                    const int nmine = ((int)blockIdx.x < MTOK / 256) ? (MTOK / 256 - 1 - (int)blockIdx.x) / (int)gridDim.x + 1 : 0;
                    asm volatile("s_waitcnt vmcnt(0)" ::: "memory");
                    __syncthreads();
                    if (nmine > 0 && threadIdx.x == 0) { __builtin_amdgcn_fence(__ATOMIC_RELEASE, "agent"); asm volatile("s_waitcnt vmcnt(0)" ::: "memory"); (void)xb_add(ctl + 64 * (1 + layer) + 32, (unsigned)nmine); }
                }
            }
            if (sub == 1) {
                asm volatile("" : "+s"(P));
                phase_attn(P, layer, lds, ctl + 64 * (1 + layer));
            } else if (sub == 2) {
                pg8::Gemm g{(const bf16_t*)(P->ws + WS_Y), (const bf16_t*)(P->ws + WS_WT_OUT) + (size_t)layer * 1024 * 1024, MTOK, DM, DM};
                pg8::StaticOrder S; S.init(MTOK, DM, (int)gridDim.x, (int)blockIdx.x);
                pg8::EpiOut E{P->x, P->out, (bf16_t*)(P->ws + WS_XB), (float*)(P->ws + WS_SSQ), (LAS float*)(lds + LDS_MISC + 8192), layer};
                if (EN & 8) pg8::gemm_phase<pg8::EpiOut, pg8::StaticOrder, true, true>(lds, g, S, E);
            }
        }
        if (ph + 1 < ph_hi) xcd_barrier(bar);
    }
}

extern "C" void kernel_launch(void* const* d_in, const int* in_sizes, int n_in, void* d_out, int out_size, void* d_ws, size_t ws_size, hipStream_t stream) {
    static int grid = 0;
    if (grid == 0) {
        if (n_in != 18 || in_sizes[0] != MTOK * DM || out_size != MTOK * DM || ws_size < WS_END) { fprintf(stderr, "kernel_launch: unexpected shapes (n_in %d, in0 %d, out %d, ws %zu)\n", n_in, n_in > 0 ? in_sizes[0] : -1, out_size, ws_size); grid = -1; return; }
        int dev = 0, cus = 0, per_cu = 0;
        (void)hipGetDevice(&dev); (void)hipDeviceGetAttribute(&cus, hipDeviceAttributeMultiprocessorCount, dev);
        if (hipFuncSetAttribute((const void*)mega_fwd, hipFuncAttributeMaxDynamicSharedMemorySize, LDS_BYTES) != hipSuccess) { fprintf(stderr, "kernel_launch: hipFuncSetAttribute failed\n"); grid = -1; return; }
        if (hipOccupancyMaxActiveBlocksPerMultiprocessor(&per_cu, (const void*)mega_fwd, 512, LDS_BYTES) != hipSuccess || per_cu < 1) { fprintf(stderr, "kernel_launch: occupancy query says %d\n", per_cu); per_cu = 1; }
        (void)hipGetLastError();
        grid = cus;
    }
    if (grid < 0) return;
#if MK_N_LAUNCHES != 1
    (void)hipMemsetAsync((char*)d_ws + WS_CTL, 0, CTL_ZERO_BYTES, stream);
#endif
    Params p{};
    const float** pp = (const float**)&p;
    for (int i = 0; i < 18; ++i) pp[i] = (const float*)d_in[i];
    p.out = (float*)d_out; p.ws = (unsigned char*)d_ws;
#if MK_N_LAUNCHES == 1
    p.ph_lo = 0; p.ph_hi = NPHASE;
    void* args[] = {&p};
    hipError_t e = hipLaunchCooperativeKernel((const void*)mega_fwd, dim3(grid), dim3(512), args, LDS_BYTES, stream);
    if (e != hipSuccess) fprintf(stderr, "cooperative launch failed: %s (grid %d)\n", hipGetErrorString(e), grid);
#else
    for (int ph = 0; ph < NPHASE; ++ph) { p.ph_lo = ph; p.ph_hi = ph + 1; hipLaunchKernelGGL(mega_fwd, dim3(grid), dim3(512), LDS_BYTES, stream, p); }
#endif
}
```

```cpp
#include <hip/hip_runtime.h>
#include <hip/hip_cooperative_groups.h>
#include <cstdio>
#include <cstdint>
namespace cg = cooperative_groups;
#ifndef EN
#define EN 0xff
#endif

constexpr int BATCH = 16, SEQ = 2048, DM = 1024, MTOK = BATCH * SEQ;
constexpr int AB_N = 4096, AB_SRC = 4104, CD_N = 3328;
constexpr float EPS = 1e-6f;
constexpr float LOG2E = 1.4426950408889634f;
constexpr float QSCALE = 0.125f * LOG2E;
__device__ __forceinline__ int opaque_tid() { int t = (int)threadIdx.x; asm volatile("" : "+v"(t)); return t; }

typedef unsigned xl_u2 __attribute__((ext_vector_type(2)));
template <int CTRL> __device__ __forceinline__ float dppf(float x) { return __int_as_float(__builtin_amdgcn_update_dpp(0, __float_as_int(x), CTRL, 0xf, 0xf, false)); }
__device__ __forceinline__ float rsum16(float x) { x += dppf<0x128>(x); x += dppf<0x124>(x); x += dppf<0x122>(x); x += dppf<0x121>(x); return x; }
__device__ __forceinline__ float rmax16(float x) { x = fmaxf(x, dppf<0x128>(x)); x = fmaxf(x, dppf<0x124>(x)); x = fmaxf(x, dppf<0x122>(x)); x = fmaxf(x, dppf<0x121>(x)); return x; }
__device__ __forceinline__ float rmin16(float x) { x = fminf(x, dppf<0x128>(x)); x = fminf(x, dppf<0x124>(x)); x = fminf(x, dppf<0x122>(x)); x = fminf(x, dppf<0x121>(x)); return x; }
__device__ __forceinline__ float xadd32(float x) { const xl_u2 r = __builtin_amdgcn_permlane32_swap(__float_as_uint(x), __float_as_uint(x), false, false); return __uint_as_float(r[0]) + __uint_as_float(r[1]); }
__device__ __forceinline__ float xadd16(float x) { const xl_u2 r = __builtin_amdgcn_permlane16_swap(__float_as_uint(x), __float_as_uint(x), false, false); return __uint_as_float(r[0]) + __uint_as_float(r[1]); }
__device__ __forceinline__ float xmax32(float x) { const xl_u2 r = __builtin_amdgcn_permlane32_swap(__float_as_uint(x), __float_as_uint(x), false, false); return fmaxf(__uint_as_float(r[0]), __uint_as_float(r[1])); }
__device__ __forceinline__ float xmax16(float x) { const xl_u2 r = __builtin_amdgcn_permlane16_swap(__float_as_uint(x), __float_as_uint(x), false, false); return fmaxf(__uint_as_float(r[0]), __uint_as_float(r[1])); }
__device__ __forceinline__ float xmin16(float x) { const xl_u2 r = __builtin_amdgcn_permlane16_swap(__float_as_uint(x), __float_as_uint(x), false, false); return fminf(__uint_as_float(r[0]), __uint_as_float(r[1])); }
namespace pg8 {
#define PG8_LAS __attribute__((address_space(3)))
typedef unsigned short bf16_t;
typedef short bf16x8 __attribute__((ext_vector_type(8)));
typedef float f32x4 __attribute__((ext_vector_type(4)));
typedef unsigned u32x4 __attribute__((ext_vector_type(4)));
constexpr int BM = 256, BK = 64, HALF = 128, HTB = HALF * BK * 2  , STAGE_BYTES = 8 * HTB, NXCD = 8, WGM = 4;

__host__ __device__ __forceinline__ int lds_byte(int r, int c) { const int st = (r >> 4) * 2 + (c >> 5), rr = r & 15, cc = c & 31, ob = rr * 64 + cc * 2; return st * 1024 + (ob ^ (((ob >> 9) & 1) << 5)); }
__host__ __device__ __forceinline__ void stage_rc(int b, int& R, int& C) { const int st = b / 1024, sb = b % 1024, swz = sb ^ (((sb >> 9) & 1) << 5); R = (st >> 1) * 16 + swz / 64; C = (st & 1) * 32 + (swz % 64) / 2; }
__host__ __device__ __forceinline__ int perm32(int rho) { const int n = rho >> 4, i = rho & 15; return 8 * (i >> 2) + 4 * n + (i & 3); }

struct Unit { int pm, pn; };
struct Gemm { const bf16_t* A; const bf16_t* Bt; int M, N, K; };

struct StaticOrder {
    int nM, nN, nwg, G, c;
    __host__ __device__ void init(int M, int N, int G_, int c_) { nM = M / BM; nN = N / BM; nwg = nM * nN; G = G_; c = c_; }
    __host__ __device__ void init_tail(int M, int pn, int G_, int c_) { nM = M / BM; nN = -pn; nwg = nM; G = G_; c = c_; }
    __host__ __device__ bool next(int i, Unit& u) const {
        const long L = (long)i * G + c; if (L >= nwg) return false;
        if (nN < 0) { u.pm = (int)L; u.pn = -nN; return true; }
        int wgid = (int)L; { const int q = nwg / NXCD, r = nwg % NXCD, xcd = wgid % NXCD, off = wgid / NXCD; wgid = (xcd < r ? xcd * (q + 1) : r * (q + 1) + (xcd - r) * q) + off; }
        const int nig = WGM * nN, gid = wgid / nig, fm = gid * WGM, gsz = (nM - fm) < WGM ? (nM - fm) : WGM;
        u.pm = fm + ((wgid % nig) % gsz); u.pn = (wgid % nig) / gsz; return true;
    }
    __device__ __forceinline__ void a_ready(const Unit&) const {}
    __device__ __forceinline__ void done(const Unit&) const {}
};


__device__ __forceinline__ unsigned cvt_pk_bf16(float lo, float hi) { typedef float f2 __attribute__((ext_vector_type(2))); typedef __bf16 b2 __attribute__((ext_vector_type(2))); f2 v = {lo, hi}; b2 b = __builtin_convertvector(v, b2); return __builtin_bit_cast(unsigned, b); }
#define PG8_EPI_BAR() do { asm volatile("s_waitcnt lgkmcnt(0)" ::: "memory"); __builtin_amdgcn_s_barrier(); asm volatile("" ::: "memory"); } while (0)

struct EpiIn {
    static constexpr bool PERM = true, AFTER_DRAIN = false;
    bf16_t* O; int ldc; const float* ssq; int cd;
    const float* gq0; const float* gk0; const float* gq1; const float* gk1;
    float* kmean; PG8_LAS float* rsl;
    __device__ __forceinline__ void prefetch(const Unit& u, int wid, int lane, int par) const {
        if (wid < 4) { unsigned keep; const void* g = ssq + (size_t)(u.pm * BM + wid * 64 + lane) * 4; const unsigned d = (unsigned)(uintptr_t)rsl + par * 4096 + wid * 1024;
            asm volatile("s_mov_b32 %0, m0\n\ts_mov_b32 m0, %2\n\ts_nop 0\n\tglobal_load_lds_dwordx4 %1, off\n\ts_mov_b32 m0, %0" : "=&s"(keep) : "v"(g), "s"(__builtin_amdgcn_readfirstlane((int)d)) : "memory"); }
    }
    template <int T>
    __device__ __forceinline__ void run(const f32x4 (&acc)[2][2][4][2], const Unit& u, int wr, int wc, int fr, int fq, int par, int gi) const {
        f32x4 gv[2][2];
#pragma unroll
        for (int bj = 0; bj < 2; ++bj)
#pragma unroll
            for (int n = 0; n < 2; ++n) gv[bj][n] = (T >= 2) ? *(const PG8_LAS f32x4*)(rsl + 2048 + gi * 64 + 32 * bj + 8 * fq + 4 * n) : (f32x4){1.f, 1.f, 1.f, 1.f};
        constexpr float qs = (T == 2) ? (0.125f * 1.4426950408889634f) : 1.0f;
        f32x4 cs[2][2];
#pragma unroll
        for (int bj = 0; bj < 2; ++bj)
#pragma unroll
            for (int n = 0; n < 2; ++n) cs[bj][n] = (f32x4){0.f, 0.f, 0.f, 0.f};
#pragma unroll
        for (int ai = 0; ai < 2; ++ai)
#pragma unroll
            for (int m = 0; m < 4; ++m) {
                const int rl = ai * HALF + wr * 64 + m * 16 + fr; const f32x4 s4 = *(const PG8_LAS f32x4*)(rsl + par * 1024 + rl * 4);
                const float rs = __builtin_amdgcn_rsqf(((s4[0] + s4[1]) + (s4[2] + s4[3])) * (1.0f / 1024.0f) + 1e-6f);
                f32x4 v[2][2];
                if constexpr (T >= 2) {
                    f32x4 q4 = acc[ai][0][m][0] * acc[ai][0][m][0];
                    q4 += acc[ai][0][m][1] * acc[ai][0][m][1]; q4 += acc[ai][1][m][0] * acc[ai][1][m][0]; q4 += acc[ai][1][m][1] * acc[ai][1][m][1];
                    float ss = (q4[0] + q4[1]) + (q4[2] + q4[3]);
                    ss = xadd16(ss); ss = xadd32(ss);
                    const float inv = rs * __builtin_amdgcn_rsqf(rs * rs * ss * (1.0f / 64.0f) + 1e-6f) * qs;
#pragma unroll
                    for (int bj = 0; bj < 2; ++bj)
#pragma unroll
                        for (int n = 0; n < 2; ++n) v[bj][n] = acc[ai][bj][m][n] * inv * gv[bj][n];
                    if constexpr (T == 4) {
#pragma unroll
                        for (int bj = 0; bj < 2; ++bj)
#pragma unroll
                            for (int n = 0; n < 2; ++n) cs[bj][n] += v[bj][n];
                    }
                } else if constexpr (T == 1) {
                    const float nrs = rs * -1.4426950408889634f;
#pragma unroll
                    for (int bj = 0; bj < 2; ++bj)
#pragma unroll
                        for (int n = 0; n < 2; ++n) { const f32x4 x = acc[ai][bj][m][n] * rs; f32x4 e = acc[ai][bj][m][n] * nrs;
#pragma unroll
                            for (int c = 0; c < 4; ++c) e[c] = __builtin_amdgcn_exp2f(e[c]);
                            e += (f32x4){1.f, 1.f, 1.f, 1.f};
#pragma unroll
                            for (int c = 0; c < 4; ++c) e[c] = __builtin_amdgcn_rcpf(e[c]);
                            v[bj][n] = x * e; }
                } else {
#pragma unroll
                    for (int bj = 0; bj < 2; ++bj)
#pragma unroll
                        for (int n = 0; n < 2; ++n) v[bj][n] = acc[ai][bj][m][n] * rs;
                }
                bf16_t* rowp = O + (size_t)(u.pn * 4 + wc) * ((size_t)32768 * 64) + (size_t)(u.pm * BM + rl) * 64 + 8 * fq;
#pragma unroll
                for (int bj = 0; bj < 2; ++bj) { u32x4 w; w.x = cvt_pk_bf16(v[bj][0][0], v[bj][0][1]); w.y = cvt_pk_bf16(v[bj][0][2], v[bj][0][3]); w.z = cvt_pk_bf16(v[bj][1][0], v[bj][1][1]); w.w = cvt_pk_bf16(v[bj][1][2], v[bj][1][3]);
                    *(u32x4*)(rowp + bj * 32) = w; }
            }
        if constexpr (T == 4) {
            const int head = (u.pn & 1) * 4 + wc;
#pragma unroll
            for (int bj = 0; bj < 2; ++bj)
#pragma unroll
                for (int n = 0; n < 2; ++n)
#pragma unroll
                    for (int e = 0; e < 4; ++e) cs[bj][n][e] = rsum16(cs[bj][n][e]);
            if (fr == 0) { float* kp = kmean + ((size_t)(u.pm * 2 + wr) * 8 + head) * 64 + 8 * fq;
#pragma unroll
                for (int bj = 0; bj < 2; ++bj)
#pragma unroll
                    for (int n = 0; n < 2; ++n) *(f32x4*)(kp + 32 * bj + 4 * n) = cs[bj][n]; }
        }
    }
    __device__ __forceinline__ void operator()(const f32x4 (&acc)[2][2][4][2], const Unit& u, int wr, int wc, int fr, int fq, int par) const {
        int type = 0; int gain = 0;
        if (!cd) { const int seg = u.pn >> 1;
            if (seg == 0) { type = 2; gain = 0; } else if (seg == 1) { type = 4; gain = 1; } else if (seg == 3 || seg == 7) type = 1;
            else if (seg == 4) { type = 2; gain = 2; } else if (seg == 5) { type = 3; gain = 3; } }
        else { const int pn = u.pn;
            if (pn < 2) { type = 2; gain = 0; } else if (pn < 4) { type = 3; gain = 1; } else if (pn < 6) type = 0; else if (pn < 8) type = 1;
            else if (pn < 10) { type = 2; gain = 2; } else if (pn == 10) { if (wc < 2) { type = 3; gain = 3; } } else type = 1; }
        type = __builtin_amdgcn_readfirstlane(type);
        if (type == 0) run<0>(acc, u, wr, wc, fr, fq, par, gain);
        else if (type == 1) run<1>(acc, u, wr, wc, fr, fq, par, gain);
        else if (type == 2) run<2>(acc, u, wr, wc, fr, fq, par, gain);
        else if (type == 3) run<3>(acc, u, wr, wc, fr, fq, par, gain);
        else run<4>(acc, u, wr, wc, fr, fq, par, gain);
    }
};

struct EpiOut {
    static constexpr bool PERM = true, AFTER_DRAIN = false;
    const float* xin; float* xout; bf16_t* xb; float* ssq; PG8_LAS float* part; int layer;
    __device__ __forceinline__ void prefetch(const Unit&, int, int, int) const {}
    template <int KIND>
    __device__ __forceinline__ void run(const f32x4 (&acc)[2][2][4][2], const Unit& u, int wr, int wc, int fr, int fq) const {
        const int tid = opaque_tid();
        const int col0 = u.pn * BM + wc * 32 + 8 * fq;
        constexpr int NB = (KIND == 0) ? 2 : 1, AIB = 2 / NB;
#pragma unroll
        for (int b = 0; b < NB; ++b) {
            f32x4 xf[(KIND == 0) ? 1 : 1][(KIND == 0) ? 4 : 1][2][2]; u32x4 xw[(KIND == 0) ? 1 : 2][4][2];
#pragma unroll
            for (int a = 0; a < AIB; ++a)
#pragma unroll
                for (int m = 0; m < 4; ++m)
#pragma unroll
                    for (int bj = 0; bj < 2; ++bj) { const int ai = b * AIB + a; const size_t off = (size_t)(u.pm * BM + ai * HALF + wr * 64 + m * 16 + fr) * 1024 + col0 + bj * HALF;
                        if constexpr (KIND == 0) { xf[0][m][bj][0] = *(const f32x4*)(xin + off); xf[0][m][bj][1] = *(const f32x4*)(xin + off + 4); }
                        else xw[a][m][bj] = *(const u32x4*)(xb + off); }
            asm volatile("" ::: "memory");
#pragma unroll
            for (int a = 0; a < AIB; ++a)
#pragma unroll
                for (int m = 0; m < 4; ++m) { const int ai = b * AIB + a;
                    const int rl = ai * HALF + wr * 64 + m * 16 + fr; const size_t off = (size_t)(u.pm * BM + rl) * 1024 + col0;
                    float ss = 0.f;
#pragma unroll
                    for (int bj = 0; bj < 2; ++bj) {
                        f32x4 x0, x1;
                        if constexpr (KIND == 0) { x0 = xf[0][m][bj][0]; x1 = xf[0][m][bj][1]; }
                        else { const u32x4 w = xw[a][m][bj];
                            x0 = (f32x4){__uint_as_float(w.x << 16), __uint_as_float(w.x & 0xffff0000u), __uint_as_float(w.y << 16), __uint_as_float(w.y & 0xffff0000u)};
                            x1 = (f32x4){__uint_as_float(w.z << 16), __uint_as_float(w.z & 0xffff0000u), __uint_as_float(w.w << 16), __uint_as_float(w.w & 0xffff0000u)}; }
                        const f32x4 v0 = acc[ai][bj][m][0] + x0, v1 = acc[ai][bj][m][1] + x1;
                        if constexpr (KIND == 2) { *(f32x4*)(xout + off + bj * HALF) = v0; *(f32x4*)(xout + off + bj * HALF + 4) = v1; }
                        else {
                            u32x4 w; w.x = cvt_pk_bf16(v0[0], v0[1]); w.y = cvt_pk_bf16(v0[2], v0[3]); w.z = cvt_pk_bf16(v1[0], v1[1]); w.w = cvt_pk_bf16(v1[2], v1[3]);
                            *(u32x4*)(xb + off + bj * HALF) = w;
                            const float r0 = __uint_as_float(w.x << 16), r1 = __uint_as_float(w.x & 0xffff0000u), r2 = __uint_as_float(w.y << 16), r3 = __uint_as_float(w.y & 0xffff0000u);
                            const float r4 = __uint_as_float(w.z << 16), r5 = __uint_as_float(w.z & 0xffff0000u), r6 = __uint_as_float(w.w << 16), r7 = __uint_as_float(w.w & 0xffff0000u);
                            ss += (r0 * r0 + r1 * r1) + (r2 * r2 + r3 * r3) + (r4 * r4 + r5 * r5) + (r6 * r6 + r7 * r7);
                        }
                    }
                    if constexpr (KIND != 2) { ss = xadd16(ss); ss = xadd32(ss); if (fq == 0) part[rl * 4 + wc] = ss; }
                }
        }
        PG8_EPI_BAR();
        if (KIND != 2 && tid < 256) { const f32x4 p4 = *(const PG8_LAS f32x4*)(part + tid * 4); ssq[(size_t)(u.pm * BM + tid) * 4 + u.pn] = (p4[0] + p4[1]) + (p4[2] + p4[3]); }
    }
    __device__ __forceinline__ void operator()(const f32x4 (&acc)[2][2][4][2], const Unit& u, int wr, int wc, int fr, int fq, int) const {
        if (layer == 0) run<0>(acc, u, wr, wc, fr, fq); else if (layer == 3) run<2>(acc, u, wr, wc, fr, fq); else run<1>(acc, u, wr, wc, fr, fq);
    }
};

template <class Epi, class Sched, bool ALIGN_EPI = false, bool SP2 = false>
__device__ __forceinline__ void gemm_phase(PG8_LAS unsigned char* lds, const Gemm g, const Sched& S, const Epi& E) {
    const int tid = opaque_tid(), wid = __builtin_amdgcn_readfirstlane(tid >> 6), lane = tid & 63, wr = wid >> 2, wc = wid & 3, fr = lane & 15, fq = lane >> 4;
    const int K = g.K, nt = K / BK;
    unsigned voffA[2], voffB[2];
#pragma unroll
    for (int i = 0; i < 2; ++i) { int R, C; stage_rc(tid * 16 + i * 8192, R, C); const int Rb = Epi::PERM ? ((R & ~31) + perm32(R & 31)) : R;
        voffA[i] = (unsigned)(R * K + C) * 2u; voffB[i] = (unsigned)(Rb * K + C) * 2u; }
    const size_t kstep = (size_t)(BK * 2);
    const size_t hstep = (size_t)HALF * K * 2;
    const size_t tstep = 2 * hstep;
    const unsigned ldsw = (unsigned)wid * 1024u;
    const int aoff = lds_byte(wr * 64 + fr, fq * 8), boff = lds_byte(wc * 32 + fr, fq * 8);
#define PG8_SA(b, h) (((b) * 2 + (h)) * HTB)
#define PG8_SB(b, h) ((4 + (b) * 2 + (h)) * HTB)
#define PG8_STAGE(bufoff, gbase, voff) do { _Pragma("unroll") for (int _i = 0; _i < 2; ++_i) \
        __builtin_amdgcn_global_load_lds((const unsigned*)((const char*)(gbase) + (voff)[_i]), (PG8_LAS unsigned*)(lds + (bufoff) + ldsw + _i * 8192), 16, 0, 0); } while (0)
#define PG8_LDA(dst, b, h) do { _Pragma("unroll") for (int m = 0; m < 4; ++m) _Pragma("unroll") for (int k = 0; k < 2; ++k) dst[m][k] = *(const PG8_LAS bf16x8*)(lds + PG8_SA(b, h) + aoff + m * 2048 + k * 1024); } while (0)
#define PG8_LDB(dst, b, h) do { _Pragma("unroll") for (int n = 0; n < 2; ++n) _Pragma("unroll") for (int k = 0; k < 2; ++k) dst[n][k] = *(const PG8_LAS bf16x8*)(lds + PG8_SB(b, h) + boff + n * 2048 + k * 1024); } while (0)
#define PG8_MMA(ai, bj, At, Bt) do { __builtin_amdgcn_s_setprio(1); _Pragma("unroll") for (int m = 0; m < 4; ++m) _Pragma("unroll") for (int n = 0; n < 2; ++n) _Pragma("unroll") for (int k = 0; k < 2; ++k) \
        acc[ai][bj][m][n] = __builtin_amdgcn_mfma_f32_16x16x32_bf16(Bt[n][k], At[m][k], acc[ai][bj][m][n], 0, 0, 0); __builtin_amdgcn_s_setprio(0); } while (0)
#define PG8_WAIT_V(n) asm volatile("s_waitcnt vmcnt(" #n ")" ::: "memory")
#define PG8_WAIT_L(n) asm volatile("s_waitcnt lgkmcnt(" #n ")" ::: "memory")
#define PG8_BAR __builtin_amdgcn_s_barrier()
#define PG8_SCHED __builtin_amdgcn_sched_barrier(0)
    Unit cur, nxt; int ui = 0;
    if (!S.next(0, cur)) return;
    f32x4 acc[2][2][4][2];
#pragma unroll
    for (int a = 0; a < 2; ++a)
#pragma unroll
        for (int b = 0; b < 2; ++b)
#pragma unroll
            for (int m = 0; m < 4; ++m)
#pragma unroll
                for (int n = 0; n < 2; ++n) acc[a][b][m][n] = (f32x4){0.f, 0.f, 0.f, 0.f};
    bf16x8 At[4][2], B0[2][2], B1[2][2];
    const char* cA = (const char*)g.A + (size_t)cur.pm * tstep; const char* cB = (const char*)g.Bt + (size_t)cur.pn * tstep;
    S.a_ready(cur);
    E.prefetch(cur, wid, lane, 0);
    if constexpr (SP2) {
        PG8_STAGE(PG8_SB(0, 0), cB, voffB); PG8_STAGE(PG8_SB(0, 1), cB + hstep, voffB); PG8_STAGE(PG8_SA(0, 0), cA, voffA); PG8_STAGE(PG8_SA(0, 1), cA + hstep, voffA);
        if (wr == 1) PG8_BAR;
        PG8_WAIT_V(2); PG8_BAR;
        PG8_STAGE(PG8_SB(1, 0), cB + kstep, voffB); PG8_STAGE(PG8_SA(1, 0), cA + kstep, voffA); PG8_STAGE(PG8_SB(1, 1), cB + hstep + kstep, voffB);
        PG8_WAIT_V(6); PG8_BAR;
    } else {
        PG8_STAGE(PG8_SB(0, 0), cB, voffB); PG8_STAGE(PG8_SA(0, 0), cA, voffA); PG8_STAGE(PG8_SB(0, 1), cB + hstep, voffB); PG8_STAGE(PG8_SA(0, 1), cA + hstep, voffA);
        if (wr == 1) PG8_BAR;
        PG8_WAIT_V(4); PG8_BAR;
        PG8_STAGE(PG8_SB(1, 0), cB + kstep, voffB); PG8_STAGE(PG8_SA(1, 0), cA + kstep, voffA); PG8_STAGE(PG8_SB(1, 1), cB + hstep + kstep, voffB);
        PG8_WAIT_V(6); PG8_BAR;
    }
    for (;;) {
        const bool has_next = S.next(ui + 1, nxt);
        const char* nA = has_next ? (const char*)g.A + (size_t)nxt.pm * tstep : cA; const char* nB = has_next ? (const char*)g.Bt + (size_t)nxt.pn * tstep : cB;
        for (int t = 0; t < nt; t += 2) {
            const bool last = (t == nt - 2);
            const char* a1 = cA + (size_t)(t + 1) * kstep;
            const char* a2 = last ? nA : cA + (size_t)(t + 2) * kstep; const char* b2 = last ? nB : cB + (size_t)(t + 2) * kstep;
            const char* a3 = a2 + kstep; const char* b3 = b2 + kstep;
            if (last && has_next) S.a_ready(nxt);
            if constexpr (SP2) {
            PG8_LDB(B0, 0, 0); PG8_LDB(B1, 0, 1); PG8_SCHED; PG8_LDA(At, 0, 0); PG8_STAGE(PG8_SA(1, 1), a1 + hstep, voffA);
            PG8_WAIT_V(8); PG8_WAIT_L(0); PG8_BAR; PG8_MMA(0, 0, At, B0); PG8_MMA(0, 1, At, B1); PG8_BAR; PG8_SCHED;
            PG8_LDA(At, 0, 1); PG8_STAGE(PG8_SB(0, 0), b2, voffB); PG8_STAGE(PG8_SB(0, 1), b2 + hstep, voffB); PG8_STAGE(PG8_SA(0, 0), a2, voffA);
            PG8_WAIT_V(8); PG8_WAIT_L(0); PG8_BAR; PG8_MMA(1, 0, At, B0); PG8_MMA(1, 1, At, B1); PG8_BAR; PG8_SCHED;
            PG8_LDB(B0, 1, 0); PG8_LDB(B1, 1, 1); PG8_SCHED; PG8_LDA(At, 1, 0); PG8_STAGE(PG8_SA(0, 1), a2 + hstep, voffA);
            PG8_WAIT_V(8); PG8_WAIT_L(0); PG8_BAR; PG8_MMA(0, 0, At, B0); PG8_MMA(0, 1, At, B1); PG8_BAR; PG8_SCHED;
            PG8_LDA(At, 1, 1); PG8_STAGE(PG8_SB(1, 0), b3, voffB); PG8_STAGE(PG8_SB(1, 1), b3 + hstep, voffB); PG8_STAGE(PG8_SA(1, 0), a3, voffA);
            PG8_WAIT_V(8); PG8_WAIT_L(0); PG8_BAR; PG8_MMA(1, 0, At, B0); PG8_MMA(1, 1, At, B1); PG8_BAR; PG8_SCHED;
            } else {
            PG8_LDB(B0, 0, 0); PG8_SCHED; PG8_LDA(At, 0, 0); PG8_STAGE(PG8_SA(1, 1), a1 + hstep, voffA);
            PG8_WAIT_L(8); PG8_BAR; PG8_WAIT_L(0); PG8_MMA(0, 0, At, B0); PG8_BAR; PG8_SCHED;
            PG8_LDB(B1, 0, 1); PG8_STAGE(PG8_SB(0, 0), b2, voffB);
            PG8_BAR; PG8_WAIT_L(0); PG8_MMA(0, 1, At, B1); PG8_BAR;
            PG8_LDA(At, 0, 1); PG8_STAGE(PG8_SA(0, 0), a2, voffA);
            PG8_BAR; PG8_WAIT_L(0); PG8_MMA(1, 0, At, B0); PG8_BAR; PG8_SCHED;
            PG8_STAGE(PG8_SB(0, 1), b2 + hstep, voffB);
            PG8_WAIT_V(6); PG8_BAR; PG8_MMA(1, 1, At, B1); PG8_BAR;
            PG8_LDB(B0, 1, 0); PG8_SCHED; PG8_LDA(At, 1, 0); PG8_STAGE(PG8_SA(0, 1), a2 + hstep, voffA);
            PG8_WAIT_L(8); PG8_BAR; PG8_WAIT_L(0); PG8_MMA(0, 0, At, B0); PG8_BAR; PG8_SCHED;
            PG8_LDB(B1, 1, 1); PG8_STAGE(PG8_SB(1, 0), b3, voffB);
            PG8_BAR; PG8_WAIT_L(0); PG8_MMA(0, 1, At, B1); PG8_BAR;
            PG8_LDA(At, 1, 1); PG8_STAGE(PG8_SA(1, 0), a3, voffA);
            PG8_BAR; PG8_WAIT_L(0); PG8_MMA(1, 0, At, B0); PG8_BAR; PG8_SCHED;
            PG8_STAGE(PG8_SB(1, 1), b3 + hstep, voffB);
            PG8_WAIT_V(6); PG8_BAR; PG8_MMA(1, 1, At, B1); PG8_BAR;
            }
        }
        if constexpr (ALIGN_EPI) { if (wr == 0) PG8_BAR; }
        if constexpr (!Epi::AFTER_DRAIN) { E(acc, cur, wr, wc, fr, fq, ui & 1); S.done(cur); }
        if (!has_next) break;
#pragma unroll
        for (int a = 0; a < 2; ++a)
#pragma unroll
            for (int b = 0; b < 2; ++b)
#pragma unroll
                for (int m = 0; m < 4; ++m)
#pragma unroll
                    for (int n = 0; n < 2; ++n) acc[a][b][m][n] = (f32x4){0.f, 0.f, 0.f, 0.f};
        cur = nxt; cA = nA; cB = nB; ++ui;
        E.prefetch(cur, wid, lane, ui & 1);
        if constexpr (ALIGN_EPI) { if (wr == 1) PG8_BAR; }
    }
    PG8_WAIT_V(0);
    if constexpr (!ALIGN_EPI) { if (wr == 0) PG8_BAR; }
    PG8_BAR;
    if constexpr (Epi::AFTER_DRAIN) { E.fused(acc, cur, wr, wc, fr, fq, lds, wid, lane); S.done(cur); }
#undef PG8_SA
#undef PG8_SB
#undef PG8_STAGE
#undef PG8_LDA
#undef PG8_LDB
#undef PG8_MMA
#undef PG8_WAIT_V
#undef PG8_WAIT_L
#undef PG8_BAR
#undef PG8_SCHED
}
}

#define LAS __attribute__((address_space(3)))
typedef LAS unsigned char* ldsp;
typedef unsigned short bf16_t;
typedef short bf16x8 __attribute__((ext_vector_type(8)));
typedef short s16x4 __attribute__((ext_vector_type(4)));
typedef float f32x4 __attribute__((ext_vector_type(4)));
typedef float f32x16 __attribute__((ext_vector_type(16)));
typedef unsigned u32x4 __attribute__((ext_vector_type(4)));
typedef unsigned u32x2 __attribute__((ext_vector_type(2)));

struct Params {
    const float* x; const float* norm_gain; const float* w_in_ab; const float* b_forget;
    const float* moba_q_gain; const float* moba_k_gain; const float* fox_q_gain; const float* fox_k_gain; const float* w_out_ab;
    const float* w_in_cd; const float* diff_q_gain; const float* diff_k_gain; const float* diff_lambda; const float* diff_subln_gain;
    const float* swa_q_gain; const float* swa_k_gain; const float* swa_sinks; const float* w_out_cd;
    float* out; unsigned char* ws; int ph_lo, ph_hi;
};
typedef const __attribute__((address_space(4))) Params* CP;
constexpr size_t MiB = 1u << 20;
constexpr size_t WS_CTL = 0, CTL_ZERO_BYTES = 128 * 1024;
constexpr int CW_PANEL = 16384;
constexpr size_t WS_WT_AB = 2 * MiB, WS_WT_CD = 18 * MiB, WS_WT_OUT = 32 * MiB, WS_WF = 40 * MiB, WS_SSQ = 41 * MiB, WS_LOGF = 43 * MiB, WS_KMEAN = 44 * MiB;
constexpr size_t WS_XB = 48 * MiB, WS_Y = 112 * MiB, WS_PROJ = 176 * MiB, WS_END = 432 * MiB;
constexpr int LDS_RING = 131072, LDS_MISC = 131072, LDS_BYTES = 155648, LDS_QW = LDS_BYTES - 64;
constexpr int NPHASE = 13;
constexpr size_t HB = (size_t)MTOK * 64;

__device__ __forceinline__ float wave_sum(float v) {
    v = rsum16(v); v = xadd16(v); v = xadd32(v);
    return v;
}
__device__ __forceinline__ float wave_max(float v) {
    v = rmax16(v); v = xmax16(v); v = xmax32(v);
    return v;
}
__device__ __forceinline__ float bf2f(unsigned short b) { return __uint_as_float((unsigned)b << 16); }
__device__ __forceinline__ unsigned pk_bf16(float lo, float hi) { return pg8::cvt_pk_bf16(lo, hi); }

__device__ __forceinline__ void transpose_item(const float* W, int ldw, int k0, int nsrc0, const float* gain, bf16_t* WT, int ndst0, LAS float* scr, int lane) {
    float wv[32];
#pragma unroll
    for (int i = 0; i < 32; ++i) { const int kk = 2 * i + (lane >> 5); wv[i] = W[(size_t)(k0 + kk) * ldw + nsrc0 + (lane & 31)]; }
    const float g0 = gain ? gain[k0 + (lane & 63)] : 1.0f;
#pragma unroll
    for (int i = 0; i < 32; ++i) { const int kk = 2 * i + (lane >> 5); scr[kk * 33 + (lane & 31)] = wv[i] * __shfl(g0, kk); }
    asm volatile("s_waitcnt lgkmcnt(0)" ::: "memory");
    const int c = lane & 7;
#pragma unroll
    for (int j = 0; j < 4; ++j) { const int n = (lane >> 3) + 8 * j; const LAS float* s = scr + (8 * c) * 33 + n;
        u32x4 o; o.x = pk_bf16(s[0 * 33], s[1 * 33]); o.y = pk_bf16(s[2 * 33], s[3 * 33]); o.z = pk_bf16(s[4 * 33], s[5 * 33]); o.w = pk_bf16(s[6 * 33], s[7 * 33]);
        *(u32x4*)(WT + (size_t)(ndst0 + n) * 1024 + k0 + 8 * c) = o; }
    asm volatile("s_waitcnt lgkmcnt(0)" ::: "memory");
}
__device__ __forceinline__ int logical_group(int nbp) { const int pn = nbp >> 3, bj = (nbp >> 2) & 1, wc = nbp & 3; return pn * 8 + wc * 2 + bj; }

constexpr int I_AB = 16 * 128, I_CD = 16 * 104, I_OUT = 16 * 32, NIT = 2 * I_AB + 2 * I_CD + 4 * I_OUT, CONV_DEFER = NIT - I_AB, CONV_TICKETS = CONV_DEFER / 32;
static_assert(CONV_DEFER % 32 == 0, "conversion tickets");
__device__ __forceinline__ void convert_item(CP P, int it, LAS float* scr, int lane) {
        int r = it;
        if (r < 2 * I_AB) { const int l = r / I_AB; r -= l * I_AB; const int kb = r / 128, nbp = r % 128;
            transpose_item(P->w_in_ab + (size_t)l * 1024 * AB_SRC, AB_SRC, kb * 64, logical_group(nbp) * 32, P->norm_gain + (2 * l) * 1024, (bf16_t*)(P->ws + WS_WT_AB) + (size_t)l * AB_N * 1024, nbp * 32, scr, lane); return; }
        r -= 2 * I_AB;
        if (r < 2 * I_CD) { const int l = r / I_CD; r -= l * I_CD; const int kb = r / 104, nbp = r % 104;
            transpose_item(P->w_in_cd + (size_t)l * 1024 * CD_N, CD_N, kb * 64, logical_group(nbp) * 32, P->norm_gain + (2 * l + 1) * 1024, (bf16_t*)(P->ws + WS_WT_CD) + (size_t)l * CD_N * 1024, nbp * 32, scr, lane); return; }
        r -= 2 * I_CD;
        { const int L = r / I_OUT; r -= L * I_OUT; const int kb = r / 32, nb = r % 32;
            const float* W = (L & 1) ? P->w_out_cd + (size_t)(L >> 1) * 1024 * 1024 : P->w_out_ab + (size_t)(L >> 1) * 1024 * 1024;
            transpose_item(W, 1024, kb * 64, nb * 32, nullptr, (bf16_t*)(P->ws + WS_WT_OUT) + (size_t)L * 1024 * 1024, nb * 32, scr, lane); }
}
__device__ __forceinline__ void phase_prologue(CP P, ldsp lds) {
    const int tid = opaque_tid(), lane = tid & 63, wid = tid >> 6;
    const int gw = blockIdx.x * 8 + wid, NGW = gridDim.x * 8;
    LAS float* scr = (LAS float*)(lds + wid * 16384);
    for (int it = gw; it < I_AB; it += NGW) convert_item(P, it, scr, lane);
    { bf16_t* WF = (bf16_t*)(P->ws + WS_WF);
      for (int i = blockIdx.x * 512 + tid; i < 2 * 16 * 1024; i += gridDim.x * 512) { const int l = i >> 14, j = (i >> 10) & 15, k = i & 1023;
          const float w = (j < 8) ? P->w_in_ab[((size_t)l * 1024 + k) * AB_SRC + 4096 + j] * P->norm_gain[(2 * l) * 1024 + k] : 0.f;
          const unsigned h = pk_bf16(w, 0.f) & 0xffffu; const float wl = w - __uint_as_float(h << 16);
          WF[(size_t)(l * 2 + 0) * 16384 + j * 1024 + k] = (bf16_t)h; WF[(size_t)(l * 2 + 1) * 16384 + j * 1024 + k] = (bf16_t)(pk_bf16(wl, 0.f) & 0xffffu); } }
    { bf16_t* XB = (bf16_t*)(P->ws + WS_XB); float* SSQ = (float*)(P->ws + WS_SSQ);
      for (int m0 = gw; m0 < MTOK; m0 += 4 * NGW) {
          f32x4 v[4][4];
#pragma unroll
          for (int q = 0; q < 4; ++q) { const int mq = (m0 + q * NGW < MTOK) ? m0 + q * NGW : m0; const f32x4* xr = (const f32x4*)(P->x + (size_t)mq * DM) + lane;
#pragma unroll
              for (int j = 0; j < 4; ++j) v[q][j] = xr[64 * j]; }
#pragma unroll
          for (int q = 0; q < 4; ++q) { const int m = m0 + q * NGW; if (m >= MTOK) break; float s = 0.f;
#pragma unroll
              for (int j = 0; j < 4; ++j) s += (v[q][j][0] * v[q][j][0] + v[q][j][1] * v[q][j][1]) + (v[q][j][2] * v[q][j][2] + v[q][j][3] * v[q][j][3]);
              s = wave_sum(s);
              if (lane == 0) *(f32x4*)(SSQ + (size_t)m * 4) = (f32x4){s, 0.f, 0.f, 0.f};
              u32x2* o8 = (u32x2*)(XB + (size_t)m * DM) + lane;
#pragma unroll
              for (int j = 0; j < 4; ++j) { u32x2 w; w.x = pk_bf16(v[q][j][0], v[q][j][1]); w.y = pk_bf16(v[q][j][2], v[q][j][3]); o8[64 * j] = w; } }
      } }
}

__device__ __forceinline__ void fgate_pass(CP P, int lj, ldsp lds) {
    typedef float f32x4v __attribute__((ext_vector_type(4)));
    const int tid = opaque_tid(), lane = tid & 63, wid = tid >> 6;
    const int gw = blockIdx.x * 8 + wid, NGW = gridDim.x * 8;
    const bf16_t* XB = (const bf16_t*)(P->ws + WS_XB); const float* SSQ = (const float*)(P->ws + WS_SSQ); float* LOGF = (float*)(P->ws + WS_LOGF);
    const int fr = lane & 15, fq = lane >> 4;
    const float bfj = (fr < 8) ? P->b_forget[lj * 8 + fr] : 0.f;
    constexpr int WROW = 2064;
    __syncthreads();
    { const u32x4* src = (const u32x4*)((const bf16_t*)(P->ws + WS_WF) + (size_t)lj * 2 * 16384);
#pragma unroll
      for (int j = 0; j < 8; ++j) { const int i = tid + 512 * j, row = i >> 7, ch = i & 127; *(LAS u32x4*)(lds + row * WROW + ch * 16) = src[i]; } }
    __syncthreads();
    for (int rg = gw; rg < MTOK / 16; rg += NGW) {
        const bf16_t* xa = XB + (size_t)(rg * 16 + fr) * DM + fq * 8;
        bf16x8 av[32];
#pragma unroll
        for (int ks = 0; ks < 32; ++ks) av[ks] = *(const bf16x8*)(xa + ks * 32);
        f32x4 s4[4];
#pragma unroll
        for (int j = 0; j < 4; ++j) s4[j] = *(const f32x4*)(SSQ + (size_t)(rg * 16 + 4 * fq + j) * 4);
        const unsigned wb = (unsigned)(uintptr_t)lds + fr * WROW + fq * 16;
        f32x4v acc = (f32x4v){0.f, 0.f, 0.f, 0.f};
#pragma unroll
        for (int c = 0; c < 8; ++c) {
            bf16x8 bh[4], bl[4];
#pragma unroll
            for (int i = 0; i < 4; ++i) { const int ks = 4 * c + i; bh[i] = *(const LAS bf16x8*)(wb + ks * 64); bl[i] = *(const LAS bf16x8*)(wb + 16 * WROW + ks * 64); }
#pragma unroll
            for (int i = 0; i < 4; ++i) { const int ks = 4 * c + i; acc = __builtin_amdgcn_mfma_f32_16x16x32_bf16(av[ks], bh[i], acc, 0, 0, 0); acc = __builtin_amdgcn_mfma_f32_16x16x32_bf16(av[ks], bl[i], acc, 0, 0, 0); }
            __builtin_amdgcn_sched_barrier(0);
        }
        if (fr < 8) {
#pragma unroll
            for (int j = 0; j < 4; ++j) { const int row = rg * 16 + 4 * fq + j;
                const float rs = 1.0f / sqrtf(((s4[j][0] + s4[j][1]) + (s4[j][2] + s4[j][3])) * (1.0f / 1024.0f) + EPS);
                const float z = acc[j] * rs + bfj; const float lf = fminf(z, 0.f) - log1pf(expf(-fabsf(z)));
                LOGF[((size_t)(row >> 11) * 8 + fr) * SEQ + (row & 2047)] = lf; }
        }
    }
}

__device__ __forceinline__ void glds16(const void* gsrc, unsigned lds_dst) { unsigned keep;
    asm volatile("s_mov_b32 %0, m0\n\ts_mov_b32 m0, %2\n\ts_nop 0\n\tglobal_load_lds_dwordx4 %1, off\n\ts_mov_b32 m0, %0" : "=&s"(keep) : "v"(gsrc), "s"(lds_dst) : "memory"); }
__device__ __forceinline__ float fadd_s(float a, float b) { asm("" : "+v"(b)); return a + b; }
__device__ __forceinline__ int crow(int r, int hi) { return (r & 3) + 8 * (r >> 2) + 4 * hi; }
__device__ __forceinline__ s16x4 vtr(unsigned addr) { typedef short v4i16_t __attribute__((ext_vector_type(4))); return __builtin_bit_cast(s16x4, __builtin_amdgcn_ds_read_tr16_b64_v4i16((LAS v4i16_t*)addr)); }

template <int VAR>
__device__ __forceinline__ void attn_unit(CP P, int lj, int ub, int uh, int uq, ldsp lds) {
    constexpr int DV = (VAR == 2) ? 128 : 64, NDB = DV / 32, NP = (VAR == 2) ? 2 : 1;
#define HM(row, col) ((size_t)((col) >> 6) * HB + (size_t)(row) * 64 + ((col) & 63))
    constexpr int KTB = (VAR == 2) ? 16384 : 8192, VTB = KTB;
    constexpr bool PIPE = (VAR < 2);
    constexpr int GP = DV * 2, GSB = 32 * GP;
    constexpr int DPF = PIPE ? 4 : 2, NS = PIPE ? DPF + 2 : DPF + 1, SLOT = KTB + VTB;
    constexpr int RINGB = (NS * SLOT < 65536) ? 65536 : NS * SLOT;
    constexpr int L_AUX = RINGB, L_WS = L_AUX + 8192, L_G = L_WS + 2048;
    static_assert(L_G + ((VAR == 2) ? 4 : 8) * GSB <= LDS_QW, "attention LDS map");
    const int tid = opaque_tid(), lane = tid & 63, wid = __builtin_amdgcn_readfirstlane(tid >> 6), r32 = lane & 31, hi = lane >> 5;
    const bf16_t* proj = (const bf16_t*)(P->ws + WS_PROJ);
    bf16_t* Y = (bf16_t*)(P->ws + WS_Y);
    const size_t rowb = (size_t)ub * SEQ;
    int colQ, colK, colV, colG, colY, wq0, t_lo, t_hi; float slope2 = 0.f; const float *gqp, *gkp;
    if constexpr (VAR == 0) { colQ = uh * 64; colK = 512 + uh * 64; colV = 1024 + uh * 64; colG = 1536 + uh * 64; colY = uh * 64; wq0 = uq * 256 + wid * 32; t_lo = 0; t_hi = 4 * uq + 4;
        slope2 = exp2f(-(float)(uh + 1)) * LOG2E; gqp = P->moba_q_gain + lj * 64; gkp = P->moba_k_gain + lj * 64; }
    else if constexpr (VAR == 1) { colQ = 2048 + uh * 64; colK = 2560 + uh * 64; colV = 3072 + uh * 64; colG = 3584 + uh * 64; colY = 512 + uh * 64; wq0 = uq * 256 + wid * 32; t_lo = 0; t_hi = 4 * uq + 4;
        gqp = P->fox_q_gain + lj * 64; gkp = P->fox_k_gain + lj * 64; }
    else if constexpr (VAR == 2) { const int c = wid >> 2; colQ = uh * 128 + c * 64; colK = 512 + uh * 128; colV = 1024 + uh * 128; colG = 1536 + uh * 128; colY = uh * 128; wq0 = uq * 128 + ((wid + 2 * c) & 3) * 32; t_lo = 0; t_hi = 2 * uq + 2;
        slope2 = exp2f(-2.0f * (float)(uh + 1)) * LOG2E; gqp = P->diff_q_gain + lj * 64; gkp = P->diff_k_gain + lj * 64; }
    else { const int hq = 4 * uh + (wid & 3); colQ = 2048 + hq * 64; colK = 2560 + uh * 64; colV = 2688 + uh * 64; colG = 2816 + hq * 64; colY = 512 + hq * 64; wq0 = uq * 64 + (wid >> 2) * 32; t_lo = uq >= 2 ? uq - 2 : 0; t_hi = uq + 1;
        slope2 = exp2f(-(float)(hq + 1)) * LOG2E; gqp = P->swa_q_gain + lj * 64; gkp = P->swa_k_gain + lj * 64; }
    const int t = wq0 + r32;
    const int twmin = wq0, twmax = wq0 + 31;
    const unsigned lds0 = (unsigned)(uintptr_t)lds;
    const int krow = 8 * wid + (lane >> 3);
    const bf16_t* kgd = proj + HM(rowb + krow, colK) + (((lane & 7) ^ ((krow >> 1) & 7)) * 8);
    const bf16_t* vgd = proj + HM(rowb + 16 * (wid & 3) + (lane >> 2), colV) + (wid >> 2) * 32 + (lane & 3) * 8;
    const int n_hi = t_hi - 1;
#define DMA_TILE(j, slot) do { int tj_ = n_hi - (j); tj_ = tj_ < t_lo ? t_lo : tj_; const size_t ro_ = (size_t)tj_ * 64 * 64; const unsigned sl_ = (unsigned)(slot) * SLOT + wid * 1024; \
        _Pragma("unroll") for (int p_ = 0; p_ < NP; ++p_) glds16(kgd + ro_ + p_ * HB, (unsigned)__builtin_amdgcn_readfirstlane((int)(lds0 + sl_ + p_ * 8192))); \
        _Pragma("unroll") for (int p_ = 0; p_ < NP; ++p_) glds16(vgd + ro_ + p_ * HB, (unsigned)__builtin_amdgcn_readfirstlane((int)(lds0 + sl_ + KTB + p_ * 8192))); } while (0)
#pragma unroll
    for (int j = 0; j < 2; ++j) DMA_TILE(j, j);
    bf16x8 qr[4];
    { const bf16_t* qrow = proj + HM(rowb + t, colQ);
#pragma unroll
      for (int d0 = 0; d0 < 4; ++d0) qr[d0] = *(const bf16x8*)(qrow + d0 * 16 + hi * 8); }
    const int dqg = (wid + 2 * (wid >> 2)) & 3;
    const unsigned gbase = lds0 + L_G + ((VAR == 2) ? dqg : wid) * GSB;
    float gqv, gkv;
    float sinkv = 0.f; if constexpr (VAR == 3) sinkv = P->swa_sinks[lj * 8 + 4 * uh + (wid & 3)];
    f32x4 lfv = (f32x4){0.f, 0.f, 0.f, 0.f}; float km0 = 0.f, km1 = 0.f;
    if constexpr (VAR == 1) lfv = *(const f32x4*)((const float*)(P->ws + WS_LOGF) + ((size_t)ub * 8 + uh) * SEQ + 4 * tid);
    if constexpr (VAR == 0) { const float* kp = (const float*)(P->ws + WS_KMEAN); const int n = tid >> 6, d = tid & 63;
        km0 = kp[((size_t)((ub * 8 + n) * 2 + 0) * 8 + uh) * 64 + d]; km1 = kp[((size_t)((ub * 8 + n) * 2 + 1) * 8 + uh) * 64 + d]; }
    { const float gq_ = gqp[lane], gk_ = gkp[lane];
      __builtin_amdgcn_sched_barrier(0);
      gqv = gq_; gkv = gk_; }
    const float M0 = 8.0f * wave_max(fabsf(gqv)) * wave_max(fabsf(gkv)) * LOG2E;
    unsigned sel = 0u; float cst = 0.f;
    if constexpr (VAR == 0) {
        if (uq >= 4) {
            LAS float* km = (LAS float*)(lds + L_AUX);
            if (tid < uq * 64) km[tid] = (km0 + km1) * (1.0f / 256.0f);
            __syncthreads();
            float g[7];
#pragma unroll
            for (int n = 0; n < 7; ++n) { float a = 0.f;
                if (n < uq) {
#pragma unroll
                    for (int d0 = 0; d0 < 4; ++d0) { const f32x4 k0 = *(const LAS f32x4*)(km + n * 64 + d0 * 16 + hi * 8), k1 = *(const LAS f32x4*)(km + n * 64 + d0 * 16 + hi * 8 + 4);
#pragma unroll
                        for (int e = 0; e < 4; ++e) { a += bf2f((unsigned short)qr[d0][e]) * k0[e]; a += bf2f((unsigned short)qr[d0][4 + e]) * k1[e]; } }
                }
                a = xadd32(a); g[n] = a; }
#pragma unroll
            for (int pick = 0; pick < 3; ++pick) { float best = -INFINITY; int bi = -1;
#pragma unroll
                for (int n = 0; n < 7; ++n) { const bool ok = (n < uq) && !((sel >> n) & 1u) && (g[n] > best); best = ok ? g[n] : best; bi = ok ? n : bi; }
                if (bi >= 0) sel |= 1u << bi; }
        } else sel = (1u << uq) - 1u;
        sel |= 1u << uq;
    }
    if constexpr (VAR == 1) {
        LAS float* cs = (LAS float*)(lds + L_AUX); LAS float* wt = (LAS float*)(lds + L_WS);
        f32x4 v = lfv;
        v[1] += v[0]; v[2] += v[1]; v[3] += v[2];
        float incl = v[3];
#pragma unroll
        for (int o = 1; o < 64; o <<= 1) { const float u = __shfl_up(incl, o); if (lane >= o) incl += u; }
        if (lane == 63) wt[wid] = incl;
        __syncthreads();
        float woff = 0.f;
#pragma unroll
        for (int w = 0; w < 8; ++w) woff += (w < wid) ? wt[w] : 0.f;
        const float ex = incl - v[3] + woff;
        *(LAS f32x4*)(cs + 4 * tid) = (f32x4){(ex + v[0]) * LOG2E, (ex + v[1]) * LOG2E, (ex + v[2]) * LOG2E, (ex + v[3]) * LOG2E};
        __syncthreads();
        cst = cs[t] - M0;
    }
    const float TH = 2.0f * M0 + 27.0f;
    float THw = TH;
    bool have_m = false;
    int t_first = t_lo; float dmax = 1e30f; float cs_wmin = 0.f;
    if constexpr (VAR == 0 || VAR == 2) {
        dmax = TH / slope2;
        const int t_umin = (VAR == 0) ? uq * 256 : uq * 128;
        const float f = ((float)t_umin - dmax - 63.0f) * (1.0f / 64.0f);
        if (f > (float)t_lo) { const int c = (int)ceilf(f); t_first = c < t_hi - 1 ? c : t_hi - 1; }
    }
    if constexpr (VAR == 1) {
        const LAS float* cs = (const LAS float*)(lds + L_AUX);
        const float cu = cs[uq * 256];
        { const int ti_ = lane & 31; const bool keep_ = (ti_ >= t_hi - 1) || ((cu - cs[ti_ * 64 + 63]) >= -TH);
          t_first = __builtin_amdgcn_readfirstlane(__builtin_ctzll(__ballot(keep_) | (1ull << 31))); }
        cs_wmin = cs[twmin];
    }
    int tw_first = 0;
#define FOX_FIRST() do { if constexpr (VAR == 1) { const int ti_ = lane & 31; const bool keep_ = (ti_ * 64 + 63 >= twmin) || ((cs_wmin - ((const LAS float*)(lds + L_AUX))[ti_ * 64 + 63]) >= -THw); \
        const unsigned long long bm_ = __ballot(keep_); tw_first = __builtin_amdgcn_readfirstlane(__builtin_ctzll(bm_ | (1ull << 31))); } } while (0)
    FOX_FIRST();
    const int n = t_hi - t_first;
    unsigned kro[4];
#pragma unroll
    for (int d0 = 0; d0 < 4; ++d0) { const int ch = 2 * d0 + hi; kro[d0] = lds0 + ((VAR == 2) ? (wid >> 2) * 8192 : 0) + r32 * 128 + ((ch ^ ((r32 >> 1) & 7)) << 4); }
    const unsigned vro = lds0 + KTB + ((lane >> 4) & 1) * 32 + (lane & 3) * 8 + (4 * hi + ((lane & 15) >> 2)) * 64;
    f32x16 o[NDB];
#pragma unroll
    for (int db = 0; db < NDB; ++db) o[db] = (f32x16){};
    float lsum = 0.f;
#define ACT(tt, out) do { const int kv0_ = (tt) * 64; bool a_ = kv0_ <= twmax; \
        if constexpr (VAR == 0 || VAR == 2) a_ = a_ && ((float)(twmin - (kv0_ + 63)) * slope2 <= THw); \
        if constexpr (VAR == 1) a_ = a_ && ((tt) >= tw_first); \
        out = a_; } while (0)
#define QK_STEP(tt, kb, P0, P1) do { const int kv0_ = (tt) * 64; bf16x8 kf[8]; \
        _Pragma("unroll") for (int d0 = 0; d0 < 4; ++d0) { kf[2 * d0] = *(const LAS bf16x8*)(kro[d0] + (kb) * SLOT); kf[2 * d0 + 1] = *(const LAS bf16x8*)(kro[d0] + (kb) * SLOT + 4096); } \
        if constexpr (VAR == 1) { const LAS float* cs_ = (const LAS float*)(lds + L_AUX) + kv0_ + 4 * hi; f32x4 c0[4], c1[4]; \
            _Pragma("unroll") for (int g4 = 0; g4 < 4; ++g4) { c0[g4] = *(const LAS f32x4*)(cs_ + 8 * g4); c1[g4] = *(const LAS f32x4*)(cs_ + 32 + 8 * g4); } \
            __builtin_amdgcn_sched_barrier(0);        \
            _Pragma("unroll") for (int g4 = 0; g4 < 4; ++g4) { _Pragma("unroll") for (int e = 0; e < 4; ++e) { P0[4 * g4 + e] = cst - c0[g4][e]; P1[4 * g4 + e] = cst - c1[g4][e]; } } \
        } else { __builtin_amdgcn_sched_barrier(0); float base = slope2 * (float)(kv0_ + 4 * hi - t) - M0; \
            if constexpr (VAR == 0) { if (!((sel >> ((tt) >> 2)) & 1u)) base = -1e30f; } \
            _Pragma("unroll") for (int r = 0; r < 16; ++r) { P0[r] = fmaf(slope2, (float)(8 * (r >> 2) + (r & 3)), base); P1[r] = fmaf(slope2, (float)(32 + 8 * (r >> 2) + (r & 3)), base); } } \
        _Pragma("unroll") for (int d0 = 0; d0 < 4; ++d0) { P0 = __builtin_amdgcn_mfma_f32_32x32x16_bf16(kf[2 * d0], qr[d0], P0, 0, 0, 0); P1 = __builtin_amdgcn_mfma_f32_32x32x16_bf16(kf[2 * d0 + 1], qr[d0], P1, 0, 0, 0); } \
    } while (0)
#define SM_STEP(tt, vb, P0, P1) do { const int kv0_ = (tt) * 64; \
        if (kv0_ + 63 > twmin) { _Pragma("unroll") for (int r = 0; r < 16; ++r) { const int kv = kv0_ + crow(r, hi); if (kv > t) P0[r] = -INFINITY; if (kv + 32 > t) P1[r] = -INFINITY; } } \
        if constexpr (VAR == 3) { if (kv0_ <= twmax - 128) { _Pragma("unroll") for (int r = 0; r < 16; ++r) { const int kv = kv0_ + crow(r, hi); if (kv <= t - 128) P0[r] = -INFINITY; if (kv + 32 <= t - 128) P1[r] = -INFINITY; } } } \
        if constexpr (VAR != 3) { if (!have_m) { float m_ = fmaxf(P0[0], P1[0]); _Pragma("unroll") for (int r = 1; r < 16; ++r) m_ = fmaxf(m_, fmaxf(P0[r], P1[r])); \
            m_ = xmax32(m_); m_ = rmin16(m_); m_ = xmin16(m_); \
            if (m_ > -1e20f) { THw = fminf(THw, 27.0f - m_); have_m = true; FOX_FIRST(); } } } \
          \
        float lacc_ = 0.f; u32x4 pwc_, pwn_ = (u32x4){0u, 0u, 0u, 0u}; s16x4 vl[NDB], vh[NDB]; \
        _Pragma("unroll") for (int e_ = 0; e_ < 8; ++e_) { P0[e_] = __builtin_amdgcn_exp2f(P0[e_]); lacc_ += P0[e_]; } \
        pwc_ = (u32x4){pk_bf16(P0[0], P0[1]), pk_bf16(P0[2], P0[3]), pk_bf16(P0[4], P0[5]), pk_bf16(P0[6], P0[7])}; \
        _Pragma("unroll") for (int ks_ = 0; ks_ < 4; ++ks_) { \
            _Pragma("unroll") for (int db = 0; db < NDB; ++db) { vl[db] = vtr(vro + (vb) * SLOT + db * 4096 + ks_ * 1024); vh[db] = vtr(vro + (vb) * SLOT + db * 4096 + ks_ * 1024 + 512); } \
            _Pragma("unroll") for (int db = 0; db < NDB; ++db) { \
                const bf16x8 vf = (bf16x8){vl[db][0], vl[db][1], vl[db][2], vl[db][3], vh[db][0], vh[db][1], vh[db][2], vh[db][3]}; \
                o[db] = __builtin_amdgcn_mfma_f32_32x32x16_bf16(__builtin_bit_cast(bf16x8, pwc_), vf, o[db], 0, 0, 0); \
                if (ks_ < 3) { constexpr int EPG = 8 / NDB;   \
                    _Pragma("unroll") for (int j_ = 0; j_ < EPG; ++j_) { const int e_ = 8 * ((ks_ + 1) & 1) + db * EPG + j_; \
                        if (ks_ + 1 < 2) { P0[e_] = __builtin_amdgcn_exp2f(P0[e_]); lacc_ += P0[e_]; } else { P1[e_] = __builtin_amdgcn_exp2f(P1[e_]); lacc_ += P1[e_]; } } \
                    if (EPG == 2) { const int e_ = 8 * ((ks_ + 1) & 1) + db * 2; pwn_[db] = (ks_ + 1 < 2) ? pk_bf16(P0[e_], P0[e_ + 1]) : pk_bf16(P1[e_], P1[e_ + 1]); } \
                    else { const int e_ = 8 * ((ks_ + 1) & 1) + db * 4; pwn_[2 * db] = (ks_ + 1 < 2) ? pk_bf16(P0[e_], P0[e_ + 1]) : pk_bf16(P1[e_], P1[e_ + 1]); pwn_[2 * db + 1] = (ks_ + 1 < 2) ? pk_bf16(P0[e_ + 2], P0[e_ + 3]) : pk_bf16(P1[e_ + 2], P1[e_ + 3]); } \
                    asm volatile("" : "+v"(lacc_), "+v"(pwn_)); } \
                __builtin_amdgcn_sched_barrier(0); } \
            pwc_ = pwn_; } \
        lsum += lacc_; \
    } while (0)
#define WAITBAR(N) asm volatile("s_waitcnt vmcnt(" #N ") lgkmcnt(0)\n\ts_barrier" ::: "memory")
#define ITER(ii, PA0, PA1, PB0, PB1) do { const int it_ = (ii), tt_ = n_hi - it_, bcur_ = sc, bnxt_ = (sc + 1 == NS) ? 0 : sc + 1; bool a0_, a1_ = false; ACT(tt_, a0_); \
        DMA_TILE(it_ + DPF, (sc == 0) ? NS - 1 : sc - 1); sc = bnxt_; \
        (void)a1_; (void)bnxt_; if (a0_) { QK_STEP(tt_, bcur_, PA0, PA1); SM_STEP(tt_, bcur_, PA0, PA1); } \
        if constexpr (NP == 2) WAITBAR(4); else WAITBAR(2); } while (0)
#define SB() __builtin_amdgcn_sched_barrier(0)
#define KLOAD2(d0, sl) do { kf[2 * (d0)] = *(const LAS bf16x8*)(kro[d0] + (sl) * SLOT); kf[2 * (d0) + 1] = *(const LAS bf16x8*)(kro[d0] + (sl) * SLOT + 4096); } while (0)
#define CINIT(tt, C0, C1) do { const int kv0_ = (tt) * 64; \
        if constexpr (VAR == 1) { const LAS float* cs_ = (const LAS float*)(lds + L_AUX) + kv0_ + 4 * hi; f32x4 c0[4]; \
            _Pragma("unroll") for (int g4 = 0; g4 < 4; ++g4) c0[g4] = *(const LAS f32x4*)(cs_ + 8 * g4); \
            SB(); \
            _Pragma("unroll") for (int g4 = 0; g4 < 4; ++g4) { _Pragma("unroll") for (int e = 0; e < 4; ++e) C0[4 * g4 + e] = cst - c0[g4][e]; } \
            _Pragma("unroll") for (int g4 = 0; g4 < 4; ++g4) c0[g4] = *(const LAS f32x4*)(cs_ + 32 + 8 * g4); \
            SB(); \
            _Pragma("unroll") for (int g4 = 0; g4 < 4; ++g4) { _Pragma("unroll") for (int e = 0; e < 4; ++e) C1[4 * g4 + e] = cst - c0[g4][e]; } \
        } else { float base = slope2 * (float)(kv0_ + 4 * hi - t) - M0; \
            if constexpr (VAR == 0) { if (!((sel >> ((tt) >> 2)) & 1u)) base = -1e30f; } \
            _Pragma("unroll") for (int r = 0; r < 16; ++r) { C0[r] = fmaf(slope2, (float)(8 * (r >> 2) + (r & 3)), base); C1[r] = fmaf(slope2, (float)(32 + 8 * (r >> 2) + (r & 3)), base); } } } while (0)
#define MASKM(tt, C0, C1) do { const int kv0_ = (tt) * 64; \
        if (kv0_ + 63 > twmin) { _Pragma("unroll") for (int r = 0; r < 16; ++r) { const int kv = kv0_ + crow(r, hi); if (kv > t) C0[r] = -INFINITY; if (kv + 32 > t) C1[r] = -INFINITY; } } \
        if constexpr (VAR == 3) { if (kv0_ <= twmax - 128) { _Pragma("unroll") for (int r = 0; r < 16; ++r) { const int kv = kv0_ + crow(r, hi); if (kv <= t - 128) C0[r] = -INFINITY; if (kv + 32 <= t - 128) C1[r] = -INFINITY; } } } \
        if constexpr (VAR != 3) { if (!have_m) { float m_ = fmaxf(C0[0], C1[0]); _Pragma("unroll") for (int r = 1; r < 16; ++r) m_ = fmaxf(m_, fmaxf(C0[r], C1[r])); \
            m_ = xmax32(m_); m_ = rmin16(m_); m_ = xmin16(m_); \
            if (m_ > -1e20f) { THw = fminf(THw, 27.0f - m_); have_m = true; FOX_FIRST(); } } } } while (0)
#define VRD(i, sl) do { vl[(i) & 3] = vtr(vro + (sl) * SLOT + ((i) >> 2) * 4096 + ((i) & 3) * 1024); vh[(i) & 3] = vtr(vro + (sl) * SLOT + ((i) >> 2) * 4096 + ((i) & 3) * 1024 + 512); } while (0)
#define VFR(i) ((bf16x8){vl[(i) & 3][0], vl[(i) & 3][1], vl[(i) & 3][2], vl[(i) & 3][3], vh[(i) & 3][0], vh[(i) & 3][1], vh[(i) & 3][2], vh[(i) & 3][3]})
#define PEL(P0, P1, k, j) (((k) < 4) ? P0[4 * ((k) & 3) + (j)] : P1[4 * ((k) & 3) + (j)])
#define QKM(k, C0, C1) do { if (((k) & 1) == 0) C0 = __builtin_amdgcn_mfma_f32_32x32x16_bf16(kf[k], qr[(k) >> 1], C0, 0, 0, 0); else C1 = __builtin_amdgcn_mfma_f32_32x32x16_bf16(kf[k], qr[(k) >> 1], C1, 0, 0, 0); } while (0)
#define SUMCVT4(k, P0, P1) do { lacc += PEL(P0, P1, k, 0); lacc += PEL(P0, P1, k, 1); lacc += PEL(P0, P1, k, 2); lacc += PEL(P0, P1, k, 3); \
        pw[(k) >> 1][((k) & 1) * 2] = pk_bf16(PEL(P0, P1, k, 0), PEL(P0, P1, k, 1)); pw[(k) >> 1][((k) & 1) * 2 + 1] = pk_bf16(PEL(P0, P1, k, 2), PEL(P0, P1, k, 3)); } while (0)
#define EXP4(k, C0, C1) do { _Pragma("unroll") for (int j_ = 0; j_ < 4; ++j_) { if ((k) < 4) C0[4 * ((k) & 3) + j_] = __builtin_amdgcn_exp2f(C0[4 * ((k) & 3) + j_]); else C1[4 * ((k) & 3) + j_] = __builtin_amdgcn_exp2f(C1[4 * ((k) & 3) + j_]); } } while (0)
#define PVM(k) do { o[(k) >> 2] = __builtin_amdgcn_mfma_f32_32x32x16_bf16(__builtin_bit_cast(bf16x8, pw[(k) & 3]), VFR(k), o[(k) >> 2], 0, 0, 0); } while (0)
#define PINV(x) asm volatile("" : "+v"(x))
#define GAPA(k, C0, C1, P0, P1, slv) do { if ((k) >= 4) VRD((k) - 4, slv); QKM(k, C0, C1); SUMCVT4(k, P0, P1); PINV(lacc); PINV(pw[(k) >> 1]); SB(); } while (0)
#define GAPB(k, C0, C1, slk, slv, dok) do { if ((k) >= 2 && (k) <= 5) KLOAD2((k) - 2, slk); PVM(k); if ((k) < 4) VRD((k) + 4, slv); EXP4(k, C0, C1); if ((k) < 4) PINV(C0); else PINV(C1); SB(); } while (0)
#define STEP(tstep, C0, C1, Pp0, Pp1) do { const int ts_ = (tstep), tt_ = n_hi - ts_; const int slc_ = sc, slp_ = (sc == 0) ? NS - 1 : sc - 1, sln_ = (sc + 1 == NS) ? 0 : sc + 1; \
        DMA_TILE(ts_ + DPF, (slp_ == 0) ? NS - 1 : slp_ - 1); sc = sln_; \
        bool a_next = false; if (ts_ + 1 < n) ACT(tt_ - 1, a_next); \
        const bool a_c = (ts_ < n) && a_cur; \
        if (a_c && a_prev) { \
            float lacc = 0.f; s16x4 vl[4], vh[4]; \
            CINIT(tt_, C0, C1); SB(); \
            GAPA(0, C0, C1, Pp0, Pp1, slp_); GAPA(1, C0, C1, Pp0, Pp1, slp_); GAPA(2, C0, C1, Pp0, Pp1, slp_); GAPA(3, C0, C1, Pp0, Pp1, slp_); \
            GAPA(4, C0, C1, Pp0, Pp1, slp_); GAPA(5, C0, C1, Pp0, Pp1, slp_); GAPA(6, C0, C1, Pp0, Pp1, slp_); GAPA(7, C0, C1, Pp0, Pp1, slp_); \
            lsum += lacc; MASKM(tt_, C0, C1); SB(); \
            GAPB(0, C0, C1, sln_, slp_, a_next); GAPB(1, C0, C1, sln_, slp_, a_next); GAPB(2, C0, C1, sln_, slp_, a_next); GAPB(3, C0, C1, sln_, slp_, a_next); \
            GAPB(4, C0, C1, sln_, slp_, a_next); GAPB(5, C0, C1, sln_, slp_, a_next); GAPB(6, C0, C1, sln_, slp_, a_next); GAPB(7, C0, C1, sln_, slp_, a_next); \
        } else { \
            if (a_c) { CINIT(tt_, C0, C1); SB(); _Pragma("unroll") for (int k_ = 0; k_ < 8; k_ += 2) { C0 = __builtin_amdgcn_mfma_f32_32x32x16_bf16(kf[k_], qr[k_ >> 1], C0, 0, 0, 0); C1 = __builtin_amdgcn_mfma_f32_32x32x16_bf16(kf[k_ + 1], qr[k_ >> 1], C1, 0, 0, 0); } } \
            if (a_prev) { float lacc = 0.f; s16x4 vl[4], vh[4]; VRD(0, slp_); VRD(1, slp_); VRD(2, slp_); VRD(3, slp_); \
                SUMCVT4(0, Pp0, Pp1); SUMCVT4(1, Pp0, Pp1); SUMCVT4(2, Pp0, Pp1); SUMCVT4(3, Pp0, Pp1); SUMCVT4(4, Pp0, Pp1); SUMCVT4(5, Pp0, Pp1); SUMCVT4(6, Pp0, Pp1); SUMCVT4(7, Pp0, Pp1); lsum += lacc; \
                PVM(0); PVM(1); PVM(2); PVM(3); VRD(4, slp_); VRD(5, slp_); VRD(6, slp_); VRD(7, slp_); PVM(4); PVM(5); PVM(6); PVM(7); } \
            if (a_c) { MASKM(tt_, C0, C1); EXP4(0, C0, C1); EXP4(1, C0, C1); EXP4(2, C0, C1); EXP4(3, C0, C1); EXP4(4, C0, C1); EXP4(5, C0, C1); EXP4(6, C0, C1); EXP4(7, C0, C1); } \
            if (a_next) { KLOAD2(0, sln_); KLOAD2(1, sln_); KLOAD2(2, sln_); KLOAD2(3, sln_); } \
        } \
        a_prev = a_c; a_cur = a_next; \
        asm volatile("s_waitcnt vmcnt(5) lgkmcnt(0)\n\ts_barrier" ::: "memory"); } while (0)
    asm volatile("" : "+v"(qr[0]), "+v"(qr[1]), "+v"(qr[2]), "+v"(qr[3]));
    asm volatile("s_waitcnt vmcnt(0) lgkmcnt(0)\n\ts_barrier" ::: "memory");
    if constexpr (PIPE) { DMA_TILE(2, 2); DMA_TILE(3, 3); }
    if (VAR != 2 || !(wid >> 2)) { constexpr int CPR = DV / 8, NG = 32 * CPR / 64;
#pragma unroll
        for (int i = 0; i < NG; ++i) { const int idx = i * 64 + lane, row = idx / CPR, ch = idx % CPR;
            glds16(proj + HM(rowb + wq0 + row, colG + ch * 8), (unsigned)__builtin_amdgcn_readfirstlane((int)(gbase + i * 1024))); } }
    f32x16 pa0, pa1, pb0, pb1; int sc = 0;
    if constexpr (PIPE) {
        bf16x8 kf[8]; u32x4 pw[4]; bool a_prev = false, a_cur;
        ACT(n_hi, a_cur);
        if (a_cur) { KLOAD2(0, 0); KLOAD2(1, 0); KLOAD2(2, 0); KLOAD2(3, 0); }
        for (int ts = 0; ts <= n; ts += 2) {
            STEP(ts, pa0, pa1, pb0, pb1);
            if (ts + 1 <= n) STEP(ts + 1, pb0, pb1, pa0, pa1);
        }
    } else {
        for (int i = 0; i < n; ++i) ITER(i, pa0, pa1, pb0, pb1);
    }
    asm volatile("s_waitcnt vmcnt(0) lgkmcnt(0)\n\ts_barrier" ::: "memory");
#undef DMA_TILE
#undef WAITBAR
#undef FOX_FIRST
#undef ACT
#undef QK_STEP
#undef SM_STEP
#undef ITER
#undef STEP
#undef GAPA
#undef PINV
#undef GAPB
#undef PVM
#undef EXP4
#undef SUMCVT4
#undef QKM
#undef PEL
#undef VFR
#undef VRD
#undef MASKM
#undef CINIT
#undef KLOAD2
#undef SB
    lsum = xadd32(lsum);
    if constexpr (VAR == 3) lsum += exp2f(sinkv * LOG2E - M0);
    LAS float* wsf = (LAS float*)(lds + L_WS) + wid * 64;
    if (hi == 0) wsf[r32] = 1.0f / lsum;
    asm volatile("s_waitcnt lgkmcnt(0)" ::: "memory");
    float rli[16];
#pragma unroll
    for (int r = 0; r < 16; ++r) rli[r] = wsf[crow(r, hi)];
#define OUT_ROWS(ost, NCH) do { asm volatile("s_waitcnt lgkmcnt(0)" ::: "memory"); \
        _Pragma("unroll") for (int i_ = 0; i_ < 32 * (NCH) / 64; ++i_) { const int idx_ = i_ * 64 + lane, row_ = idx_ / (NCH), ch_ = idx_ % (NCH); \
            const f32x4 a_ = *(const LAS f32x4*)((ost) + row_ * DV + ch_ * 8), b_ = *(const LAS f32x4*)((ost) + row_ * DV + ch_ * 8 + 4); \
            const u32x4 g_ = *(const LAS u32x4*)(gbase + row_ * GP + ch_ * 16); u32x4 w_; \
            w_.x = pk_bf16(a_[0] * __uint_as_float(g_.x << 16), a_[1] * __uint_as_float(g_.x & 0xffff0000u)); w_.y = pk_bf16(a_[2] * __uint_as_float(g_.y << 16), a_[3] * __uint_as_float(g_.y & 0xffff0000u)); \
            w_.z = pk_bf16(b_[0] * __uint_as_float(g_.z << 16), b_[1] * __uint_as_float(g_.z & 0xffff0000u)); w_.w = pk_bf16(b_[2] * __uint_as_float(g_.w << 16), b_[3] * __uint_as_float(g_.w & 0xffff0000u)); \
            *(u32x4*)(Y + (rowb + wq0 + row_) * DM + colY + ch_ * 8) = w_; } } while (0)
    if constexpr (VAR != 2) {
        LAS float* ost = (LAS float*)lds + wid * 2048;
#pragma unroll
        for (int r = 0; r < 16; ++r)
#pragma unroll
            for (int db = 0; db < NDB; ++db) ost[crow(r, hi) * DV + db * 32 + r32] = o[db][r] * rli[r];
        OUT_ROWS(ost, 8);
        __syncthreads();
    } else {
        int ljo = lj; asm volatile("" : "+s"(ljo));
        const float* lp = P->diff_lambda + ljo * 256; const int layer = 2 * ljo + 1;
        const float lam_init = 0.8f - 0.6f * expf(-0.3f * (float)layer);
        const float lam = expf(wave_sum(lp[lane] * lp[64 + lane])) - expf(wave_sum(lp[128 + lane] * lp[192 + lane])) + lam_init;
        LAS float* ex = (LAS float*)lds + dqg * 4096;
        if (wid >> 2) {
#pragma unroll
            for (int db = 0; db < NDB; ++db)
#pragma unroll
                for (int r = 0; r < 16; ++r) ex[(db * 16 + r) * 64 + lane] = o[db][r] * rli[r];
        }
        __syncthreads();
        if (!(wid >> 2)) {
            float ss[16];
#pragma unroll
            for (int r = 0; r < 16; ++r) { float a = 0.f;
#pragma unroll
                for (int db = 0; db < NDB; ++db) { const float v = o[db][r] * rli[r] - lam * ex[(db * 16 + r) * 64 + lane]; o[db][r] = v; a += v * v; }
                a = rsum16(a); a = xadd16(a);
                ss[r] = __builtin_amdgcn_rsqf(a * (1.0f / 128.0f) + EPS) * (1.0f - lam_init); }
            float sg[NDB];
#pragma unroll
            for (int db = 0; db < NDB; ++db) sg[db] = P->diff_subln_gain[lj * 128 + db * 32 + r32];
            asm volatile("s_waitcnt lgkmcnt(0)" ::: "memory");
            LAS float* ost = ex;
#pragma unroll
            for (int r = 0; r < 16; ++r)
#pragma unroll
                for (int db = 0; db < NDB; ++db) ost[crow(r, hi) * DV + db * 32 + r32] = o[db][r] * ss[r] * sg[db];
            OUT_ROWS(ost, 16);
        }
        __syncthreads();
    }
#undef OUT_ROWS
}

__device__ __forceinline__ void phase_attn(CP P, int layer, ldsp lds, unsigned* ctr) {
    const int tid = opaque_tid(); const int lj = layer >> 1;
    volatile LAS unsigned* qw = (volatile LAS unsigned*)(lds + LDS_QW);
    const unsigned G = gridDim.x;
    unsigned nxt = blockIdx.x;
    if (tid == 0) qw[8] = 0u;
    for (;;) {
        if (tid == 0) *qw = nxt;
        __syncthreads();
        const unsigned u = *qw;
        __syncthreads();
        unsigned ua = u;
        if (layer == 0) {
            if (u >= 2048u + CONV_TICKETS) break;
            if (u < 9u * CONV_TICKETS) { if (u % 9u == 8u) ua = 0xffffffffu; else ua = u - (u + 1u) / 9u; } else ua = u - CONV_TICKETS;
        } else if (u >= 2048u) break;
        const bool pre = true;
        if (pre && tid == 0) nxt = atomicAdd(ctr, 1u) + G;
        if (ua == 0xffffffffu) {
            const int tc = opaque_tid(), lane = tc & 63, wid = __builtin_amdgcn_readfirstlane(tc >> 6); LAS float* scr = (LAS float*)(lds + wid * 16384);
            CP Pc = P; asm volatile("" : "+s"(Pc));
            const int it0 = I_AB + __builtin_amdgcn_readfirstlane((int)(u / 9u)) * 32 + wid * 4;
#pragma nounroll
            for (int j = 0; j < 4; ++j) convert_item(Pc, it0 + j, scr, lane);
        } else if (!(layer & 1)) { const int qb = 7 - (int)(ua >> 8), r = ua & 255, kind = r >> 7, b = (r >> 3) & 15, h = r & 7;
            if (kind == 0) { if (EN & 16) attn_unit<0>(P, lj, b, h, qb, lds); } else { if (EN & 32) attn_unit<1>(P, lj, b, h, qb, lds); } }
        else { if (u < 1024u) { const int qb = 15 - (int)(u >> 6), r = u & 63; if (EN & 64) attn_unit<2>(P, lj, r >> 2, r & 3, qb, lds); }
            else { if (qw[8] == 0u) {
                    if (tid == 0) { unsigned sp_ = 0; while (__hip_atomic_load(ctr + 32, __ATOMIC_RELAXED, __HIP_MEMORY_SCOPE_AGENT) < (unsigned)(MTOK / 256)) { __builtin_amdgcn_s_sleep(2); if (++sp_ > (1u << 22)) break; }
                        __builtin_amdgcn_fence(__ATOMIC_ACQUIRE, "agent"); asm volatile("s_waitcnt vmcnt(0)" ::: "memory"); }
                    __syncthreads(); if (tid == 0) qw[8] = 1u; }
              const unsigned v = u - 1024u; const int qb = 31 - (int)(v >> 5), r = v & 31; if (EN & 128) attn_unit<3>(P, lj, r >> 1, r & 1, qb, lds); } }
        if (!pre && tid == 0) nxt = atomicAdd(ctr, 1u) + G;
    }
}

#define XB_TMO      128
#define XB_XCNT(j)  (256  + 64 * (j))
#define XB_XSUB(j)  (1280 + 64 * (j))
#define XB_XGEN(j)  (2304 + 64 * (j))
#define XB_TOP      3328
#define XB_TOPGEN   3392
#define XCD_BAR_WORDS 3456
#define XB_SPIN_CAP (1u << 18)

__device__ __forceinline__ unsigned xb_ld(unsigned* p)              { return __hip_atomic_load(p, __ATOMIC_RELAXED, __HIP_MEMORY_SCOPE_AGENT); }
__device__ __forceinline__ unsigned xb_add(unsigned* p, unsigned v) { return __hip_atomic_fetch_add(p, v, __ATOMIC_RELAXED, __HIP_MEMORY_SCOPE_AGENT); }
__device__ __forceinline__ unsigned xb_xcc_id() { return (unsigned)__builtin_amdgcn_s_getreg((3 << 11) | 20) & 0xFu; }
#define XB_SPIN(cond, bar) do { unsigned _sp = 0; while (cond) { __builtin_amdgcn_s_sleep(1); \
    if ((++_sp & 255u) == 0u) { if (xb_ld(&(bar)[XB_TMO])) break; if (_sp > XB_SPIN_CAP) { atomicAdd(&(bar)[XB_TMO], 1u); break; } } } } while (0)

struct XcdBarrier {
    unsigned* bar; unsigned x;
    volatile LAS unsigned* st;
};

__device__ __forceinline__ XcdBarrier xcd_barrier_post(unsigned* bar, volatile LAS unsigned* st) {
    XcdBarrier b; b.bar = bar; b.x = xb_xcc_id(); b.st = st;
    if (threadIdx.x == 0) (void)xb_add(&bar[XB_XCNT(b.x)], 1u);
    return b;
}
__device__ __forceinline__ void xcd_barrier_complete(unsigned* bar, unsigned x, unsigned& nloc, unsigned& nx) {
    const unsigned G = gridDim.x * gridDim.y * gridDim.z;
    unsigned sum, cnt, mine, sp = 0u;
    for (;;) {
        sum = 0u; cnt = 0u; mine = 0u;
        unsigned cj[16]; { const unsigned* mid = &bar[XB_XCNT(8)];
          asm volatile("global_load_dword %0, %16, off offset:-2048 sc1\n\tglobal_load_dword %1, %16, off offset:-1792 sc1\n\tglobal_load_dword %2, %16, off offset:-1536 sc1\n\tglobal_load_dword %3, %16, off offset:-1280 sc1\n\t"
                       "global_load_dword %4, %16, off offset:-1024 sc1\n\tglobal_load_dword %5, %16, off offset:-768 sc1\n\tglobal_load_dword %6, %16, off offset:-512 sc1\n\tglobal_load_dword %7, %16, off offset:-256 sc1\n\t"
                       "global_load_dword %8, %16, off sc1\n\tglobal_load_dword %9, %16, off offset:256 sc1\n\tglobal_load_dword %10, %16, off offset:512 sc1\n\tglobal_load_dword %11, %16, off offset:768 sc1\n\t"
                       "global_load_dword %12, %16, off offset:1024 sc1\n\tglobal_load_dword %13, %16, off offset:1280 sc1\n\tglobal_load_dword %14, %16, off offset:1536 sc1\n\tglobal_load_dword %15, %16, off offset:1792 sc1\n\t"
                       "s_waitcnt vmcnt(0)"
                       : "=&v"(cj[0]), "=&v"(cj[1]), "=&v"(cj[2]), "=&v"(cj[3]), "=&v"(cj[4]), "=&v"(cj[5]), "=&v"(cj[6]), "=&v"(cj[7]),
                         "=&v"(cj[8]), "=&v"(cj[9]), "=&v"(cj[10]), "=&v"(cj[11]), "=&v"(cj[12]), "=&v"(cj[13]), "=&v"(cj[14]), "=&v"(cj[15])
                       : "v"(mid) : "memory"); }
#pragma unroll
        for (unsigned j = 0; j < 16; ++j) { const unsigned c = cj[j]; sum += c; cnt += (c > 0u) ? 1u : 0u; mine = (j == x) ? c : mine; }
        if (sum == G) break;
        __builtin_amdgcn_s_sleep(1);
        if ((++sp & 255u) == 0u) { if (xb_ld(&bar[XB_TMO])) break; if (sp > XB_SPIN_CAP) { atomicAdd(&bar[XB_TMO], 1u); break; } }
    }
    nloc = mine > 0u ? mine : 1u; nx = cnt > 0u ? cnt : 1u;
}

__device__ __forceinline__ void xcd_barrier(const XcdBarrier& b) {
    asm volatile("s_waitcnt vmcnt(0)" ::: "memory");
    __syncthreads();
    if (threadIdx.x == 0) {
        unsigned* bar = b.bar;
        __builtin_amdgcn_s_waitcnt(0);
        unsigned nloc = b.st[0], nx = b.st[1];
        if (nloc == 0u) { xcd_barrier_complete(bar, b.x, nloc, nx); b.st[0] = nloc; b.st[1] = nx; }
        const unsigned old = xb_add(&bar[XB_XSUB(b.x)], 1u);
        const unsigned gen = old / nloc;
        if (old + 1u == (gen + 1u) * nloc) {
            __builtin_amdgcn_fence(__ATOMIC_RELEASE, "agent");
            asm volatile("s_waitcnt vmcnt(0)" ::: "memory");
            const unsigned og = xb_add(&bar[XB_TOP], 1u);
            const unsigned tg = og / nx;
            if (og + 1u == (tg + 1u) * nx) xb_add(&bar[XB_TOPGEN], 1u);
            else XB_SPIN(xb_ld(&bar[XB_TOPGEN]) == tg, bar);
            __builtin_amdgcn_fence(__ATOMIC_ACQUIRE, "agent");
            xb_add(&bar[XB_XGEN(b.x)], 1u);
            asm volatile("s_waitcnt vmcnt(0)" ::: "memory");
        } else {
            XB_SPIN(xb_ld(&bar[XB_XGEN(b.x)]) == gen, bar);
            __builtin_amdgcn_fence(__ATOMIC_ACQUIRE, "agent");
            asm volatile("s_waitcnt vmcnt(0)" ::: "memory");
        }
    }
    __syncthreads();
}


#ifndef MK_N_LAUNCHES
#define MK_N_LAUNCHES 1
#endif
__global__ void __launch_bounds__(512, 2) mega_fwd(Params Pv) {
    CP P = (CP)__builtin_amdgcn_kernarg_segment_ptr(); (void)Pv;
    extern __shared__ __attribute__((aligned(16))) unsigned char lds_raw[];
    ldsp lds = (ldsp)lds_raw;
    cg::grid_group grid = cg::this_grid();
    unsigned* ctl = (unsigned*)(P->ws + WS_CTL);
    volatile LAS unsigned* bst = (volatile LAS unsigned*)(lds + LDS_QW + 16);
    if (threadIdx.x < 2) bst[threadIdx.x] = 0u;
    __syncthreads();
#if MK_N_LAUNCHES == 1
    for (unsigned i = blockIdx.x * 512u + threadIdx.x; i < CTL_ZERO_BYTES / 4; i += gridDim.x * 512u) ctl[i] = 0u;
    grid.sync();
#endif
    XcdBarrier bar = xcd_barrier_post(ctl + 4096, bst);
    const int ph_lo = P->ph_lo, ph_hi = P->ph_hi;
    for (int ph = ph_lo; ph < ph_hi; ++ph) {
        asm volatile("" : "+s"(P));
        if (ph == 0) { if (EN & 1) phase_prologue(P, lds); }
        else {
            const int layer = (ph - 1) / 3, sub = (ph - 1) % 3, lj = layer >> 1, cd = layer & 1;
            if (sub == 0 || (sub == 1 && cd)) {
                pg8::Gemm g{(const bf16_t*)(P->ws + WS_XB), cd ? (const bf16_t*)(P->ws + WS_WT_CD) + (size_t)lj * CD_N * 1024 : (const bf16_t*)(P->ws + WS_WT_AB) + (size_t)lj * AB_N * 1024, MTOK, cd ? CD_N : AB_N, DM};
                pg8::StaticOrder S; if (sub == 0) S.init(MTOK, cd ? CD_N - 256 : AB_N, (int)gridDim.x, (int)blockIdx.x); else S.init_tail(MTOK, CD_N / 256 - 1, (int)gridDim.x, (int)blockIdx.x);
                pg8::EpiIn E{(bf16_t*)(P->ws + WS_PROJ), cd ? CD_N : AB_N, (const float*)(P->ws + WS_SSQ), cd,
                             cd ? P->diff_q_gain + lj * 64 : P->moba_q_gain + lj * 64, cd ? P->diff_k_gain + lj * 64 : P->moba_k_gain + lj * 64,
                             cd ? P->swa_q_gain + lj * 64 : P->fox_q_gain + lj * 64, cd ? P->swa_k_gain + lj * 64 : P->fox_k_gain + lj * 64,
                             (float*)(P->ws + WS_KMEAN), (LAS float*)(lds + LDS_MISC)};
                { const int t = opaque_tid();
                  if (t < 256) { const float* gp = t < 64 ? E.gq0 : t < 128 ? E.gk0 : t < 192 ? E.gq1 : E.gk1; ((LAS float*)(lds + LDS_MISC + 8192))[t] = gp[t & 63]; }
                  __syncthreads(); }
                if (EN & 2) pg8::gemm_phase<pg8::EpiIn, pg8::StaticOrder, true, true>(lds, g, S, E);
                if (sub == 0) { if (EN & 4) if (!cd) fgate_pass(P, lj, lds); }
                else {
                    const int nmine = ((int)blockIdx.x < MTOK / 256) ? (MTOK / 256 - 1 - (int)blockIdx.x) / (int)gridDim.x + 1 : 0;
                    asm volatile("s_waitcnt vmcnt(0)" ::: "memory");
                    __syncthreads();
                    if (nmine > 0 && threadIdx.x == 0) { __builtin_amdgcn_fence(__ATOMIC_RELEASE, "agent"); asm volatile("s_waitcnt vmcnt(0)" ::: "memory"); (void)xb_add(ctl + 64 * (1 + layer) + 32, (unsigned)nmine); }
                }
            }
            if (sub == 1) {
                asm volatile("" : "+s"(P));
                phase_attn(P, layer, lds, ctl + 64 * (1 + layer));
            } else if (sub == 2) {
                pg8::Gemm g{(const bf16_t*)(P->ws + WS_Y), (const bf16_t*)(P->ws + WS_WT_OUT) + (size_t)layer * 1024 * 1024, MTOK, DM, DM};
                pg8::StaticOrder S; S.init(MTOK, DM, (int)gridDim.x, (int)blockIdx.x);
                pg8::EpiOut E{P->x, P->out, (bf16_t*)(P->ws + WS_XB), (float*)(P->ws + WS_SSQ), (LAS float*)(lds + LDS_MISC + 8192), layer};
                if (EN & 8) pg8::gemm_phase<pg8::EpiOut, pg8::StaticOrder, true, true>(lds, g, S, E);
            }
        }
        if (ph + 1 < ph_hi) xcd_barrier(bar);
    }
}

extern "C" void kernel_launch(void* const* d_in, const int* in_sizes, int n_in, void* d_out, int out_size, void* d_ws, size_t ws_size, hipStream_t stream) {
    static int grid = 0;
    if (grid == 0) {
        if (n_in != 18 || in_sizes[0] != MTOK * DM || out_size != MTOK * DM || ws_size < WS_END) { fprintf(stderr, "kernel_launch: unexpected shapes (n_in %d, in0 %d, out %d, ws %zu)\n", n_in, n_in > 0 ? in_sizes[0] : -1, out_size, ws_size); grid = -1; return; }
        int dev = 0, cus = 0, per_cu = 0;
        (void)hipGetDevice(&dev); (void)hipDeviceGetAttribute(&cus, hipDeviceAttributeMultiprocessorCount, dev);
        if (hipFuncSetAttribute((const void*)mega_fwd, hipFuncAttributeMaxDynamicSharedMemorySize, LDS_BYTES) != hipSuccess) { fprintf(stderr, "kernel_launch: hipFuncSetAttribute failed\n"); grid = -1; return; }
        if (hipOccupancyMaxActiveBlocksPerMultiprocessor(&per_cu, (const void*)mega_fwd, 512, LDS_BYTES) != hipSuccess || per_cu < 1) { fprintf(stderr, "kernel_launch: occupancy query says %d\n", per_cu); per_cu = 1; }
        (void)hipGetLastError();
        grid = cus;
    }
    if (grid < 0) return;
#if MK_N_LAUNCHES != 1
    (void)hipMemsetAsync((char*)d_ws + WS_CTL, 0, CTL_ZERO_BYTES, stream);
#endif
    Params p{};
    const float** pp = (const float**)&p;
    for (int i = 0; i < 18; ++i) pp[i] = (const float*)d_in[i];
    p.out = (float*)d_out; p.ws = (unsigned char*)d_ws;
#if MK_N_LAUNCHES == 1
    p.ph_lo = 0; p.ph_hi = NPHASE;
    void* args[] = {&p};
    hipError_t e = hipLaunchCooperativeKernel((const void*)mega_fwd, dim3(grid), dim3(512), args, LDS_BYTES, stream);
    if (e != hipSuccess) fprintf(stderr, "cooperative launch failed: %s (grid %d)\n", hipGetErrorString(e), grid);
#else
    for (int ph = 0; ph < NPHASE; ++ph) { p.ph_lo = ph; p.ph_hi = ph + 1; hipLaunchKernelGGL(mega_fwd, dim3(grid), dim3(512), LDS_BYTES, stream, p); }
#endif
}
```

```cpp
#include <hip/hip_runtime.h>
#include <hip/hip_cooperative_groups.h>
#include <cstdio>
#include <cstdint>
namespace cg = cooperative_groups;
#ifndef EN
#define EN 0xff
#endif

constexpr int BATCH = 16, SEQ = 2048, DM = 1024, MTOK = BATCH * SEQ;
constexpr int AB_N = 4096, AB_SRC = 4104, CD_N = 3328;
constexpr float EPS = 1e-6f;
constexpr float LOG2E = 1.4426950408889634f;
constexpr float QSCALE = 0.125f * LOG2E;
__device__ __forceinline__ int opaque_tid() { int t = (int)threadIdx.x; asm volatile("" : "+v"(t)); return t; }

typedef unsigned xl_u2 __attribute__((ext_vector_type(2)));
template <int CTRL> __device__ __forceinline__ float dppf(float x) { return __int_as_float(__builtin_amdgcn_update_dpp(0, __float_as_int(x), CTRL, 0xf, 0xf, false)); }
__device__ __forceinline__ float rsum16(float x) { x += dppf<0x128>(x); x += dppf<0x124>(x); x += dppf<0x122>(x); x += dppf<0x121>(x); return x; }
__device__ __forceinline__ float rmax16(float x) { x = fmaxf(x, dppf<0x128>(x)); x = fmaxf(x, dppf<0x124>(x)); x = fmaxf(x, dppf<0x122>(x)); x = fmaxf(x, dppf<0x121>(x)); return x; }
__device__ __forceinline__ float rmin16(float x) { x = fminf(x, dppf<0x128>(x)); x = fminf(x, dppf<0x124>(x)); x = fminf(x, dppf<0x122>(x)); x = fminf(x, dppf<0x121>(x)); return x; }
__device__ __forceinline__ float xadd32(float x) { const xl_u2 r = __builtin_amdgcn_permlane32_swap(__float_as_uint(x), __float_as_uint(x), false, false); return __uint_as_float(r[0]) + __uint_as_float(r[1]); }
__device__ __forceinline__ float xadd16(float x) { const xl_u2 r = __builtin_amdgcn_permlane16_swap(__float_as_uint(x), __float_as_uint(x), false, false); return __uint_as_float(r[0]) + __uint_as_float(r[1]); }
__device__ __forceinline__ float xmax32(float x) { const xl_u2 r = __builtin_amdgcn_permlane32_swap(__float_as_uint(x), __float_as_uint(x), false, false); return fmaxf(__uint_as_float(r[0]), __uint_as_float(r[1])); }
__device__ __forceinline__ float xmax16(float x) { const xl_u2 r = __builtin_amdgcn_permlane16_swap(__float_as_uint(x), __float_as_uint(x), false, false); return fmaxf(__uint_as_float(r[0]), __uint_as_float(r[1])); }
__device__ __forceinline__ float xmin16(float x) { const xl_u2 r = __builtin_amdgcn_permlane16_swap(__float_as_uint(x), __float_as_uint(x), false, false); return fminf(__uint_as_float(r[0]), __uint_as_float(r[1])); }
namespace pg8 {
#define PG8_LAS __attribute__((address_space(3)))
typedef unsigned short bf16_t;
typedef short bf16x8 __attribute__((ext_vector_type(8)));
typedef float f32x4 __attribute__((ext_vector_type(4)));
typedef unsigned u32x4 __attribute__((ext_vector_type(4)));
constexpr int BM = 256, BK = 64, HALF = 128, HTB = HALF * BK * 2  , STAGE_BYTES = 8 * HTB, NXCD = 8, WGM = 4;

__host__ __device__ __forceinline__ int lds_byte(int r, int c) { const int st = (r >> 4) * 2 + (c >> 5), rr = r & 15, cc = c & 31, ob = rr * 64 + cc * 2; return st * 1024 + (ob ^ (((ob >> 9) & 1) << 5)); }
__host__ __device__ __forceinline__ void stage_rc(int b, int& R, int& C) { const int st = b / 1024, sb = b % 1024, swz = sb ^ (((sb >> 9) & 1) << 5); R = (st >> 1) * 16 + swz / 64; C = (st & 1) * 32 + (swz % 64) / 2; }
__host__ __device__ __forceinline__ int perm32(int rho) { const int n = rho >> 4, i = rho & 15; return 8 * (i >> 2) + 4 * n + (i & 3); }

struct Unit { int pm, pn; };
struct Gemm { const bf16_t* A; const bf16_t* Bt; int M, N, K; };

struct StaticOrder {
    int nM, nN, nwg, G, c;
    __host__ __device__ void init(int M, int N, int G_, int c_) { nM = M / BM; nN = N / BM; nwg = nM * nN; G = G_; c = c_; }
    __host__ __device__ void init_tail(int M, int pn, int G_, int c_) { nM = M / BM; nN = -pn; nwg = nM; G = G_; c = c_; }
    __host__ __device__ bool next(int i, Unit& u) const {
        const long L = (long)i * G + c; if (L >= nwg) return false;
        if (nN < 0) { u.pm = (int)L; u.pn = -nN; return true; }
        int wgid = (int)L; { const int q = nwg / NXCD, r = nwg % NXCD, xcd = wgid % NXCD, off = wgid / NXCD; wgid = (xcd < r ? xcd * (q + 1) : r * (q + 1) + (xcd - r) * q) + off; }
        const int nig = WGM * nN, gid = wgid / nig, fm = gid * WGM, gsz = (nM - fm) < WGM ? (nM - fm) : WGM;
        u.pm = fm + ((wgid % nig) % gsz); u.pn = (wgid % nig) / gsz; return true;
    }
    __device__ __forceinline__ void a_ready(const Unit&) const {}
    __device__ __forceinline__ void done(const Unit&) const {}
};


__device__ __forceinline__ unsigned cvt_pk_bf16(float lo, float hi) { typedef float f2 __attribute__((ext_vector_type(2))); typedef __bf16 b2 __attribute__((ext_vector_type(2))); f2 v = {lo, hi}; b2 b = __builtin_convertvector(v, b2); return __builtin_bit_cast(unsigned, b); }
#define PG8_EPI_BAR() do { asm volatile("s_waitcnt lgkmcnt(0)" ::: "memory"); __builtin_amdgcn_s_barrier(); asm volatile("" ::: "memory"); } while (0)

struct EpiIn {
    static constexpr bool PERM = true, AFTER_DRAIN = false;
    bf16_t* O; int ldc; const float* ssq; int cd;
    const float* gq0; const float* gk0; const float* gq1; const float* gk1;
    float* kmean; PG8_LAS float* rsl;
    __device__ __forceinline__ void prefetch(const Unit& u, int wid, int lane, int par) const {
        if (wid < 4) { unsigned keep; const void* g = ssq + (size_t)(u.pm * BM + wid * 64 + lane) * 4; const unsigned d = (unsigned)(uintptr_t)rsl + par * 4096 + wid * 1024;
            asm volatile("s_mov_b32 %0, m0\n\ts_mov_b32 m0, %2\n\ts_nop 0\n\tglobal_load_lds_dwordx4 %1, off\n\ts_mov_b32 m0, %0" : "=&s"(keep) : "v"(g), "s"(__builtin_amdgcn_readfirstlane((int)d)) : "memory"); }
    }
    template <int T>
    __device__ __forceinline__ void run(const f32x4 (&acc)[2][2][4][2], const Unit& u, int wr, int wc, int fr, int fq, int par, int gi) const {
        f32x4 gv[2][2];
#pragma unroll
        for (int bj = 0; bj < 2; ++bj)
#pragma unroll
            for (int n = 0; n < 2; ++n) gv[bj][n] = (T >= 2) ? *(const PG8_LAS f32x4*)(rsl + 2048 + gi * 64 + 32 * bj + 8 * fq + 4 * n) : (f32x4){1.f, 1.f, 1.f, 1.f};
        constexpr float qs = (T == 2) ? (0.125f * 1.4426950408889634f) : 1.0f;
        f32x4 cs[2][2];
#pragma unroll
        for (int bj = 0; bj < 2; ++bj)
#pragma unroll
            for (int n = 0; n < 2; ++n) cs[bj][n] = (f32x4){0.f, 0.f, 0.f, 0.f};
#pragma unroll
        for (int ai = 0; ai < 2; ++ai)
#pragma unroll
            for (int m = 0; m < 4; ++m) {
                const int rl = ai * HALF + wr * 64 + m * 16 + fr; const f32x4 s4 = *(const PG8_LAS f32x4*)(rsl + par * 1024 + rl * 4);
                const float rs = __builtin_amdgcn_rsqf(((s4[0] + s4[1]) + (s4[2] + s4[3])) * (1.0f / 1024.0f) + 1e-6f);
                f32x4 v[2][2];
                if constexpr (T >= 2) {
                    f32x4 q4 = acc[ai][0][m][0] * acc[ai][0][m][0];
                    q4 += acc[ai][0][m][1] * acc[ai][0][m][1]; q4 += acc[ai][1][m][0] * acc[ai][1][m][0]; q4 += acc[ai][1][m][1] * acc[ai][1][m][1];
                    float ss = (q4[0] + q4[1]) + (q4[2] + q4[3]);
                    ss = xadd16(ss); ss = xadd32(ss);
                    const float inv = rs * __builtin_amdgcn_rsqf(rs * rs * ss * (1.0f / 64.0f) + 1e-6f) * qs;
#pragma unroll
                    for (int bj = 0; bj < 2; ++bj)
#pragma unroll
                        for (int n = 0; n < 2; ++n) v[bj][n] = acc[ai][bj][m][n] * inv * gv[bj][n];
                    if constexpr (T == 4) {
#pragma unroll
                        for (int bj = 0; bj < 2; ++bj)
#pragma unroll
                            for (int n = 0; n < 2; ++n) cs[bj][n] += v[bj][n];
                    }
                } else if constexpr (T == 1) {
                    const float nrs = rs * -1.4426950408889634f;
#pragma unroll
                    for (int bj = 0; bj < 2; ++bj)
#pragma unroll
                        for (int n = 0; n < 2; ++n) { const f32x4 x = acc[ai][bj][m][n] * rs; f32x4 e = acc[ai][bj][m][n] * nrs;
#pragma unroll
                            for (int c = 0; c < 4; ++c) e[c] = __builtin_amdgcn_exp2f(e[c]);
                            e += (f32x4){1.f, 1.f, 1.f, 1.f};
#pragma unroll
                            for (int c = 0; c < 4; ++c) e[c] = __builtin_amdgcn_rcpf(e[c]);
                            v[bj][n] = x * e; }
                } else {
#pragma unroll
                    for (int bj = 0; bj < 2; ++bj)
#pragma unroll
                        for (int n = 0; n < 2; ++n) v[bj][n] = acc[ai][bj][m][n] * rs;
                }
                bf16_t* rowp = O + (size_t)(u.pn * 4 + wc) * ((size_t)32768 * 64) + (size_t)(u.pm * BM + rl) * 64 + 8 * fq;
#pragma unroll
                for (int bj = 0; bj < 2; ++bj) { u32x4 w; w.x = cvt_pk_bf16(v[bj][0][0], v[bj][0][1]); w.y = cvt_pk_bf16(v[bj][0][2], v[bj][0][3]); w.z = cvt_pk_bf16(v[bj][1][0], v[bj][1][1]); w.w = cvt_pk_bf16(v[bj][1][2], v[bj][1][3]);
                    *(u32x4*)(rowp + bj * 32) = w; }
            }
        if constexpr (T == 4) {
            const int head = (u.pn & 1) * 4 + wc;
#pragma unroll
            for (int bj = 0; bj < 2; ++bj)
#pragma unroll
                for (int n = 0; n < 2; ++n)
#pragma unroll
                    for (int e = 0; e < 4; ++e) cs[bj][n][e] = rsum16(cs[bj][n][e]);
            if (fr == 0) { float* kp = kmean + ((size_t)(u.pm * 2 + wr) * 8 + head) * 64 + 8 * fq;
#pragma unroll
                for (int bj = 0; bj < 2; ++bj)
#pragma unroll
                    for (int n = 0; n < 2; ++n) *(f32x4*)(kp + 32 * bj + 4 * n) = cs[bj][n]; }
        }
    }
    __device__ __forceinline__ void operator()(const f32x4 (&acc)[2][2][4][2], const Unit& u, int wr, int wc, int fr, int fq, int par) const {
        int type = 0; int gain = 0;
        if (!cd) { const int seg = u.pn >> 1;
            if (seg == 0) { type = 2; gain = 0; } else if (seg == 1) { type = 4; gain = 1; } else if (seg == 3 || seg == 7) type = 1;
            else if (seg == 4) { type = 2; gain = 2; } else if (seg == 5) { type = 3; gain = 3; } }
        else { const int pn = u.pn;
            if (pn < 2) { type = 2; gain = 0; } else if (pn < 4) { type = 3; gain = 1; } else if (pn < 6) type = 0; else if (pn < 8) type = 1;
            else if (pn < 10) { type = 2; gain = 2; } else if (pn == 10) { if (wc < 2) { type = 3; gain = 3; } } else type = 1; }
        type = __builtin_amdgcn_readfirstlane(type);
        if (type == 0) run<0>(acc, u, wr, wc, fr, fq, par, gain);
        else if (type == 1) run<1>(acc, u, wr, wc, fr, fq, par, gain);
        else if (type == 2) run<2>(acc, u, wr, wc, fr, fq, par, gain);
        else if (type == 3) run<3>(acc, u, wr, wc, fr, fq, par, gain);
        else run<4>(acc, u, wr, wc, fr, fq, par, gain);
    }
};

struct EpiOut {
    static constexpr bool PERM = true, AFTER_DRAIN = false;
    const float* xin; float* xout; bf16_t* xb; float* ssq; PG8_LAS float* part; int layer;
    __device__ __forceinline__ void prefetch(const Unit&, int, int, int) const {}
    template <int KIND>
    __device__ __forceinline__ void run(const f32x4 (&acc)[2][2][4][2], const Unit& u, int wr, int wc, int fr, int fq) const {
        const int tid = opaque_tid();
        const int col0 = u.pn * BM + wc * 32 + 8 * fq;
        constexpr int NB = (KIND == 0) ? 2 : 1, AIB = 2 / NB;
#pragma unroll
        for (int b = 0; b < NB; ++b) {
            f32x4 xf[(KIND == 0) ? 1 : 1][(KIND == 0) ? 4 : 1][2][2]; u32x4 xw[(KIND == 0) ? 1 : 2][4][2];
#pragma unroll
            for (int a = 0; a < AIB; ++a)
#pragma unroll
                for (int m = 0; m < 4; ++m)
#pragma unroll
                    for (int bj = 0; bj < 2; ++bj) { const int ai = b * AIB + a; const size_t off = (size_t)(u.pm * BM + ai * HALF + wr * 64 + m * 16 + fr) * 1024 + col0 + bj * HALF;
                        if constexpr (KIND == 0) { xf[0][m][bj][0] = *(const f32x4*)(xin + off); xf[0][m][bj][1] = *(const f32x4*)(xin + off + 4); }
                        else xw[a][m][bj] = *(const u32x4*)(xb + off); }
            asm volatile("" ::: "memory");
#pragma unroll
            for (int a = 0; a < AIB; ++a)
#pragma unroll
                for (int m = 0; m < 4; ++m) { const int ai = b * AIB + a;
                    const int rl = ai * HALF + wr * 64 + m * 16 + fr; const size_t off = (size_t)(u.pm * BM + rl) * 1024 + col0;
                    float ss = 0.f;
#pragma unroll
                    for (int bj = 0; bj < 2; ++bj) {
                        f32x4 x0, x1;
                        if constexpr (KIND == 0) { x0 = xf[0][m][bj][0]; x1 = xf[0][m][bj][1]; }
                        else { const u32x4 w = xw[a][m][bj];
                            x0 = (f32x4){__uint_as_float(w.x << 16), __uint_as_float(w.x & 0xffff0000u), __uint_as_float(w.y << 16), __uint_as_float(w.y & 0xffff0000u)};
                            x1 = (f32x4){__uint_as_float(w.z << 16), __uint_as_float(w.z & 0xffff0000u), __uint_as_float(w.w << 16), __uint_as_float(w.w & 0xffff0000u)}; }
                        const f32x4 v0 = acc[ai][bj][m][0] + x0, v1 = acc[ai][bj][m][1] + x1;
                        if constexpr (KIND == 2) { *(f32x4*)(xout + off + bj * HALF) = v0; *(f32x4*)(xout + off + bj * HALF + 4) = v1; }
                        else {
                            u32x4 w; w.x = cvt_pk_bf16(v0[0], v0[1]); w.y = cvt_pk_bf16(v0[2], v0[3]); w.z = cvt_pk_bf16(v1[0], v1[1]); w.w = cvt_pk_bf16(v1[2], v1[3]);
                            *(u32x4*)(xb + off + bj * HALF) = w;
                            const float r0 = __uint_as_float(w.x << 16), r1 = __uint_as_float(w.x & 0xffff0000u), r2 = __uint_as_float(w.y << 16), r3 = __uint_as_float(w.y & 0xffff0000u);
                            const float r4 = __uint_as_float(w.z << 16), r5 = __uint_as_float(w.z & 0xffff0000u), r6 = __uint_as_float(w.w << 16), r7 = __uint_as_float(w.w & 0xffff0000u);
                            ss += (r0 * r0 + r1 * r1) + (r2 * r2 + r3 * r3) + (r4 * r4 + r5 * r5) + (r6 * r6 + r7 * r7);
                        }
                    }
                    if constexpr (KIND != 2) { ss = xadd16(ss); ss = xadd32(ss); if (fq == 0) part[rl * 4 + wc] = ss; }
                }
        }
        PG8_EPI_BAR();
        if (KIND != 2 && tid < 256) { const f32x4 p4 = *(const PG8_LAS f32x4*)(part + tid * 4); ssq[(size_t)(u.pm * BM + tid) * 4 + u.pn] = (p4[0] + p4[1]) + (p4[2] + p4[3]); }
    }
    __device__ __forceinline__ void operator()(const f32x4 (&acc)[2][2][4][2], const Unit& u, int wr, int wc, int fr, int fq, int) const {
        if (layer == 0) run<0>(acc, u, wr, wc, fr, fq); else if (layer == 3) run<2>(acc, u, wr, wc, fr, fq); else run<1>(acc, u, wr, wc, fr, fq);
    }
};

template <class Epi, class Sched, bool ALIGN_EPI = false, bool SP2 = false>
__device__ __forceinline__ void gemm_phase(PG8_LAS unsigned char* lds, const Gemm g, const Sched& S, const Epi& E) {
    const int tid = opaque_tid(), wid = __builtin_amdgcn_readfirstlane(tid >> 6), lane = tid & 63, wr = wid >> 2, wc = wid & 3, fr = lane & 15, fq = lane >> 4;
    const int K = g.K, nt = K / BK;
    unsigned voffA[2], voffB[2];
#pragma unroll
    for (int i = 0; i < 2; ++i) { int R, C; stage_rc(tid * 16 + i * 8192, R, C); const int Rb = Epi::PERM ? ((R & ~31) + perm32(R & 31)) : R;
        voffA[i] = (unsigned)(R * K + C) * 2u; voffB[i] = (unsigned)(Rb * K + C) * 2u; }
    const size_t kstep = (size_t)(BK * 2);
    const size_t hstep = (size_t)HALF * K * 2;
    const size_t tstep = 2 * hstep;
    const unsigned ldsw = (unsigned)wid * 1024u;
    const int aoff = lds_byte(wr * 64 + fr, fq * 8), boff = lds_byte(wc * 32 + fr, fq * 8);
#define PG8_SA(b, h) (((b) * 2 + (h)) * HTB)
#define PG8_SB(b, h) ((4 + (b) * 2 + (h)) * HTB)
#define PG8_STAGE(bufoff, gbase, voff) do { _Pragma("unroll") for (int _i = 0; _i < 2; ++_i) \
        __builtin_amdgcn_global_load_lds((const unsigned*)((const char*)(gbase) + (voff)[_i]), (PG8_LAS unsigned*)(lds + (bufoff) + ldsw + _i * 8192), 16, 0, 0); } while (0)
#define PG8_LDA(dst, b, h) do { _Pragma("unroll") for (int m = 0; m < 4; ++m) _Pragma("unroll") for (int k = 0; k < 2; ++k) dst[m][k] = *(const PG8_LAS bf16x8*)(lds + PG8_SA(b, h) + aoff + m * 2048 + k * 1024); } while (0)
#define PG8_LDB(dst, b, h) do { _Pragma("unroll") for (int n = 0; n < 2; ++n) _Pragma("unroll") for (int k = 0; k < 2; ++k) dst[n][k] = *(const PG8_LAS bf16x8*)(lds + PG8_SB(b, h) + boff + n * 2048 + k * 1024); } while (0)
#define PG8_MMA(ai, bj, At, Bt) do { __builtin_amdgcn_s_setprio(1); _Pragma("unroll") for (int m = 0; m < 4; ++m) _Pragma("unroll") for (int n = 0; n < 2; ++n) _Pragma("unroll") for (int k = 0; k < 2; ++k) \
        acc[ai][bj][m][n] = __builtin_amdgcn_mfma_f32_16x16x32_bf16(Bt[n][k], At[m][k], acc[ai][bj][m][n], 0, 0, 0); __builtin_amdgcn_s_setprio(0); } while (0)
#define PG8_WAIT_V(n) asm volatile("s_waitcnt vmcnt(" #n ")" ::: "memory")
#define PG8_WAIT_L(n) asm volatile("s_waitcnt lgkmcnt(" #n ")" ::: "memory")
#define PG8_BAR __builtin_amdgcn_s_barrier()
#define PG8_SCHED __builtin_amdgcn_sched_barrier(0)
    Unit cur, nxt; int ui = 0;
    if (!S.next(0, cur)) return;
    f32x4 acc[2][2][4][2];
#pragma unroll
    for (int a = 0; a < 2; ++a)
#pragma unroll
        for (int b = 0; b < 2; ++b)
#pragma unroll
            for (int m = 0; m < 4; ++m)
#pragma unroll
                for (int n = 0; n < 2; ++n) acc[a][b][m][n] = (f32x4){0.f, 0.f, 0.f, 0.f};
    bf16x8 At[4][2], B0[2][2], B1[2][2];
    const char* cA = (const char*)g.A + (size_t)cur.pm * tstep; const char* cB = (const char*)g.Bt + (size_t)cur.pn * tstep;
    S.a_ready(cur);
    E.prefetch(cur, wid, lane, 0);
    if constexpr (SP2) {
        PG8_STAGE(PG8_SB(0, 0), cB, voffB); PG8_STAGE(PG8_SB(0, 1), cB + hstep, voffB); PG8_STAGE(PG8_SA(0, 0), cA, voffA); PG8_STAGE(PG8_SA(0, 1), cA + hstep, voffA);
        if (wr == 1) PG8_BAR;
        PG8_WAIT_V(2); PG8_BAR;
        PG8_STAGE(PG8_SB(1, 0), cB + kstep, voffB); PG8_STAGE(PG8_SA(1, 0), cA + kstep, voffA); PG8_STAGE(PG8_SB(1, 1), cB + hstep + kstep, voffB);
        PG8_WAIT_V(6); PG8_BAR;
    } else {
        PG8_STAGE(PG8_SB(0, 0), cB, voffB); PG8_STAGE(PG8_SA(0, 0), cA, voffA); PG8_STAGE(PG8_SB(0, 1), cB + hstep, voffB); PG8_STAGE(PG8_SA(0, 1), cA + hstep, voffA);
        if (wr == 1) PG8_BAR;
        PG8_WAIT_V(4); PG8_BAR;
        PG8_STAGE(PG8_SB(1, 0), cB + kstep, voffB); PG8_STAGE(PG8_SA(1, 0), cA + kstep, voffA); PG8_STAGE(PG8_SB(1, 1), cB + hstep + kstep, voffB);
        PG8_WAIT_V(6); PG8_BAR;
    }
    for (;;) {
        const bool has_next = S.next(ui + 1, nxt);
        const char* nA = has_next ? (const char*)g.A + (size_t)nxt.pm * tstep : cA; const char* nB = has_next ? (const char*)g.Bt + (size_t)nxt.pn * tstep : cB;
        for (int t = 0; t < nt; t += 2) {
            const bool last = (t == nt - 2);
            const char* a1 = cA + (size_t)(t + 1) * kstep;
            const char* a2 = last ? nA : cA + (size_t)(t + 2) * kstep; const char* b2 = last ? nB : cB + (size_t)(t + 2) * kstep;
            const char* a3 = a2 + kstep; const char* b3 = b2 + kstep;
            if (last && has_next) S.a_ready(nxt);
            if constexpr (SP2) {
            PG8_LDB(B0, 0, 0); PG8_LDB(B1, 0, 1); PG8_SCHED; PG8_LDA(At, 0, 0); PG8_STAGE(PG8_SA(1, 1), a1 + hstep, voffA);
            PG8_WAIT_V(8); PG8_WAIT_L(0); PG8_BAR; PG8_MMA(0, 0, At, B0); PG8_MMA(0, 1, At, B1); PG8_BAR; PG8_SCHED;
            PG8_LDA(At, 0, 1); PG8_STAGE(PG8_SB(0, 0), b2, voffB); PG8_STAGE(PG8_SB(0, 1), b2 + hstep, voffB); PG8_STAGE(PG8_SA(0, 0), a2, voffA);
            PG8_WAIT_V(8); PG8_WAIT_L(0); PG8_BAR; PG8_MMA(1, 0, At, B0); PG8_MMA(1, 1, At, B1); PG8_BAR; PG8_SCHED;
            PG8_LDB(B0, 1, 0); PG8_LDB(B1, 1, 1); PG8_SCHED; PG8_LDA(At, 1, 0); PG8_STAGE(PG8_SA(0, 1), a2 + hstep, voffA);
            PG8_WAIT_V(8); PG8_WAIT_L(0); PG8_BAR; PG8_MMA(0, 0, At, B0); PG8_MMA(0, 1, At, B1); PG8_BAR; PG8_SCHED;
            PG8_LDA(At, 1, 1); PG8_STAGE(PG8_SB(1, 0), b3, voffB); PG8_STAGE(PG8_SB(1, 1), b3 + hstep, voffB); PG8_STAGE(PG8_SA(1, 0), a3, voffA);
            PG8_WAIT_V(8); PG8_WAIT_L(0); PG8_BAR; PG8_MMA(1, 0, At, B0); PG8_MMA(1, 1, At, B1); PG8_BAR; PG8_SCHED;
            } else {
            PG8_LDB(B0, 0, 0); PG8_SCHED; PG8_LDA(At, 0, 0); PG8_STAGE(PG8_SA(1, 1), a1 + hstep, voffA);
            PG8_WAIT_L(8); PG8_BAR; PG8_WAIT_L(0); PG8_MMA(0, 0, At, B0); PG8_BAR; PG8_SCHED;
            PG8_LDB(B1, 0, 1); PG8_STAGE(PG8_SB(0, 0), b2, voffB);
            PG8_BAR; PG8_WAIT_L(0); PG8_MMA(0, 1, At, B1); PG8_BAR;
            PG8_LDA(At, 0, 1); PG8_STAGE(PG8_SA(0, 0), a2, voffA);
            PG8_BAR; PG8_WAIT_L(0); PG8_MMA(1, 0, At, B0); PG8_BAR; PG8_SCHED;
            PG8_STAGE(PG8_SB(0, 1), b2 + hstep, voffB);
            PG8_WAIT_V(6); PG8_BAR; PG8_MMA(1, 1, At, B1); PG8_BAR;
            PG8_LDB(B0, 1, 0); PG8_SCHED; PG8_LDA(At, 1, 0); PG8_STAGE(PG8_SA(0, 1), a2 + hstep, voffA);
            PG8_WAIT_L(8); PG8_BAR; PG8_WAIT_L(0); PG8_MMA(0, 0, At, B0); PG8_BAR; PG8_SCHED;
            PG8_LDB(B1, 1, 1); PG8_STAGE(PG8_SB(1, 0), b3, voffB);
            PG8_BAR; PG8_WAIT_L(0); PG8_MMA(0, 1, At, B1); PG8_BAR;
            PG8_LDA(At, 1, 1); PG8_STAGE(PG8_SA(1, 0), a3, voffA);
            PG8_BAR; PG8_WAIT_L(0); PG8_MMA(1, 0, At, B0); PG8_BAR; PG8_SCHED;
            PG8_STAGE(PG8_SB(1, 1), b3 + hstep, voffB);
            PG8_WAIT_V(6); PG8_BAR; PG8_MMA(1, 1, At, B1); PG8_BAR;
            }
        }
        if constexpr (ALIGN_EPI) { if (wr == 0) PG8_BAR; }
        if constexpr (!Epi::AFTER_DRAIN) { E(acc, cur, wr, wc, fr, fq, ui & 1); S.done(cur); }
        if (!has_next) break;
#pragma unroll
        for (int a = 0; a < 2; ++a)
#pragma unroll
            for (int b = 0; b < 2; ++b)
#pragma unroll
                for (int m = 0; m < 4; ++m)
#pragma unroll
                    for (int n = 0; n < 2; ++n) acc[a][b][m][n] = (f32x4){0.f, 0.f, 0.f, 0.f};
        cur = nxt; cA = nA; cB = nB; ++ui;
        E.prefetch(cur, wid, lane, ui & 1);
        if constexpr (ALIGN_EPI) { if (wr == 1) PG8_BAR; }
    }
    PG8_WAIT_V(0);
    if constexpr (!ALIGN_EPI) { if (wr == 0) PG8_BAR; }
    PG8_BAR;
    if constexpr (Epi::AFTER_DRAIN) { E.fused(acc, cur, wr, wc, fr, fq, lds, wid, lane); S.done(cur); }
#undef PG8_SA
#undef PG8_SB
#undef PG8_STAGE
#undef PG8_LDA
#undef PG8_LDB
#undef PG8_MMA
#undef PG8_WAIT_V
#undef PG8_WAIT_L
#undef PG8_BAR
#undef PG8_SCHED
}
}

#define LAS __attribute__((address_space(3)))
typedef LAS unsigned char* ldsp;
typedef unsigned short bf16_t;
typedef short bf16x8 __attribute__((ext_vector_type(8)));
typedef short s16x4 __attribute__((ext_vector_type(4)));
typedef float f32x4 __attribute__((ext_vector_type(4)));
typedef float f32x16 __attribute__((ext_vector_type(16)));
typedef unsigned u32x4 __attribute__((ext_vector_type(4)));
typedef unsigned u32x2 __attribute__((ext_vector_type(2)));

struct Params {
    const float* x; const float* norm_gain; const float* w_in_ab; const float* b_forget;
    const float* moba_q_gain; const float* moba_k_gain; const float* fox_q_gain; const float* fox_k_gain; const float* w_out_ab;
    const float* w_in_cd; const float* diff_q_gain; const float* diff_k_gain; const float* diff_lambda; const float* diff_subln_gain;
    const float* swa_q_gain; const float* swa_k_gain; const float* swa_sinks; const float* w_out_cd;
    float* out; unsigned char* ws; int ph_lo, ph_hi;
};
typedef const __attribute__((address_space(4))) Params* CP;
constexpr size_t MiB = 1u << 20;
constexpr size_t WS_CTL = 0, CTL_ZERO_BYTES = 128 * 1024;
constexpr int CW_PANEL = 16384;
constexpr size_t WS_WT_AB = 2 * MiB, WS_WT_CD = 18 * MiB, WS_WT_OUT = 32 * MiB, WS_WF = 40 * MiB, WS_SSQ = 41 * MiB, WS_LOGF = 43 * MiB, WS_KMEAN = 44 * MiB;
constexpr size_t WS_XB = 48 * MiB, WS_Y = 112 * MiB, WS_PROJ = 176 * MiB, WS_END = 432 * MiB;
constexpr int LDS_RING = 131072, LDS_MISC = 131072, LDS_BYTES = 155648, LDS_QW = LDS_BYTES - 64;
constexpr int NPHASE = 13;
constexpr size_t HB = (size_t)MTOK * 64;

__device__ __forceinline__ float wave_sum(float v) {
    v = rsum16(v); v = xadd16(v); v = xadd32(v);
    return v;
}
__device__ __forceinline__ float wave_max(float v) {
    v = rmax16(v); v = xmax16(v); v = xmax32(v);
    return v;
}
__device__ __forceinline__ float bf2f(unsigned short b) { return __uint_as_float((unsigned)b << 16); }
__device__ __forceinline__ unsigned pk_bf16(float lo, float hi) { return pg8::cvt_pk_bf16(lo, hi); }

__device__ __forceinline__ void transpose_item(const float* W, int ldw, int k0, int nsrc0, const float* gain, bf16_t* WT, int ndst0, LAS float* scr, int lane) {
    float wv[32];
#pragma unroll
    for (int i = 0; i < 32; ++i) { const int kk = 2 * i + (lane >> 5); wv[i] = W[(size_t)(k0 + kk) * ldw + nsrc0 + (lane & 31)]; }
    const float g0 = gain ? gain[k0 + (lane & 63)] : 1.0f;
#pragma unroll
    for (int i = 0; i < 32; ++i) { const int kk = 2 * i + (lane >> 5); scr[kk * 33 + (lane & 31)] = wv[i] * __shfl(g0, kk); }
    asm volatile("s_waitcnt lgkmcnt(0)" ::: "memory");
    const int c = lane & 7;
#pragma unroll
    for (int j = 0; j < 4; ++j) { const int n = (lane >> 3) + 8 * j; const LAS float* s = scr + (8 * c) * 33 + n;
        u32x4 o; o.x = pk_bf16(s[0 * 33], s[1 * 33]); o.y = pk_bf16(s[2 * 33], s[3 * 33]); o.z = pk_bf16(s[4 * 33], s[5 * 33]); o.w = pk_bf16(s[6 * 33], s[7 * 33]);
        *(u32x4*)(WT + (size_t)(ndst0 + n) * 1024 + k0 + 8 * c) = o; }
    asm volatile("s_waitcnt lgkmcnt(0)" ::: "memory");
}
__device__ __forceinline__ int logical_group(int nbp) { const int pn = nbp >> 3, bj = (nbp >> 2) & 1, wc = nbp & 3; return pn * 8 + wc * 2 + bj; }

constexpr int I_AB = 16 * 128, I_CD = 16 * 104, I_OUT = 16 * 32, NIT = 2 * I_AB + 2 * I_CD + 4 * I_OUT, CONV_DEFER = NIT - I_AB, CONV_TICKETS = CONV_DEFER / 32;
static_assert(CONV_DEFER % 32 == 0, "conversion tickets");
__device__ __forceinline__ void convert_item(CP P, int it, LAS float* scr, int lane) {
        int r = it;
        if (r < 2 * I_AB) { const int l = r / I_AB; r -= l * I_AB; const int kb = r / 128, nbp = r % 128;
            transpose_item(P->w_in_ab + (size_t)l * 1024 * AB_SRC, AB_SRC, kb * 64, logical_group(nbp) * 32, P->norm_gain + (2 * l) * 1024, (bf16_t*)(P->ws + WS_WT_AB) + (size_t)l * AB_N * 1024, nbp * 32, scr, lane); return; }
        r -= 2 * I_AB;
        if (r < 2 * I_CD) { const int l = r / I_CD; r -= l * I_CD; const int kb = r / 104, nbp = r % 104;
            transpose_item(P->w_in_cd + (size_t)l * 1024 * CD_N, CD_N, kb * 64, logical_group(nbp) * 32, P->norm_gain + (2 * l + 1) * 1024, (bf16_t*)(P->ws + WS_WT_CD) + (size_t)l * CD_N * 1024, nbp * 32, scr, lane); return; }
        r -= 2 * I_CD;
        { const int L = r / I_OUT; r -= L * I_OUT; const int kb = r / 32, nb = r % 32;
            const float* W = (L & 1) ? P->w_out_cd + (size_t)(L >> 1) * 1024 * 1024 : P->w_out_ab + (size_t)(L >> 1) * 1024 * 1024;
            transpose_item(W, 1024, kb * 64, nb * 32, nullptr, (bf16_t*)(P->ws + WS_WT_OUT) + (size_t)L * 1024 * 1024, nb * 32, scr, lane); }
}
__device__ __forceinline__ void phase_prologue(CP P, ldsp lds) {
    const int tid = opaque_tid(), lane = tid & 63, wid = tid >> 6;
    const int gw = blockIdx.x * 8 + wid, NGW = gridDim.x * 8;
    LAS float* scr = (LAS float*)(lds + wid * 16384);
    for (int it = gw; it < I_AB; it += NGW) convert_item(P, it, scr, lane);
    { bf16_t* WF = (bf16_t*)(P->ws + WS_WF);
      for (int i = blockIdx.x * 512 + tid; i < 2 * 16 * 1024; i += gridDim.x * 512) { const int l = i >> 14, j = (i >> 10) & 15, k = i & 1023;
          const float w = (j < 8) ? P->w_in_ab[((size_t)l * 1024 + k) * AB_SRC + 4096 + j] * P->norm_gain[(2 * l) * 1024 + k] : 0.f;
          const unsigned h = pk_bf16(w, 0.f) & 0xffffu; const float wl = w - __uint_as_float(h << 16);
          WF[(size_t)(l * 2 + 0) * 16384 + j * 1024 + k] = (bf16_t)h; WF[(size_t)(l * 2 + 1) * 16384 + j * 1024 + k] = (bf16_t)(pk_bf16(wl, 0.f) & 0xffffu); } }
    { bf16_t* XB = (bf16_t*)(P->ws + WS_XB); float* SSQ = (float*)(P->ws + WS_SSQ);
      for (int m0 = gw; m0 < MTOK; m0 += 4 * NGW) {
          f32x4 v[4][4];
#pragma unroll
          for (int q = 0; q < 4; ++q) { const int mq = (m0 + q * NGW < MTOK) ? m0 + q * NGW : m0; const f32x4* xr = (const f32x4*)(P->x + (size_t)mq * DM) + lane;
#pragma unroll
              for (int j = 0; j < 4; ++j) v[q][j] = xr[64 * j]; }
#pragma unroll
          for (int q = 0; q < 4; ++q) { const int m = m0 + q * NGW; if (m >= MTOK) break; float s = 0.f;
#pragma unroll
              for (int j = 0; j < 4; ++j) s += (v[q][j][0] * v[q][j][0] + v[q][j][1] * v[q][j][1]) + (v[q][j][2] * v[q][j][2] + v[q][j][3] * v[q][j][3]);
              s = wave_sum(s);
              if (lane == 0) *(f32x4*)(SSQ + (size_t)m * 4) = (f32x4){s, 0.f, 0.f, 0.f};
              u32x2* o8 = (u32x2*)(XB + (size_t)m * DM) + lane;
#pragma unroll
              for (int j = 0; j < 4; ++j) { u32x2 w; w.x = pk_bf16(v[q][j][0], v[q][j][1]); w.y = pk_bf16(v[q][j][2], v[q][j][3]); o8[64 * j] = w; } }
      } }
}

__device__ __forceinline__ void fgate_pass(CP P, int lj, ldsp lds) {
    typedef float f32x4v __attribute__((ext_vector_type(4)));
    const int tid = opaque_tid(), lane = tid & 63, wid = tid >> 6;
    const int gw = blockIdx.x * 8 + wid, NGW = gridDim.x * 8;
    const bf16_t* XB = (const bf16_t*)(P->ws + WS_XB); const float* SSQ = (const float*)(P->ws + WS_SSQ); float* LOGF = (float*)(P->ws + WS_LOGF);
    const int fr = lane & 15, fq = lane >> 4;
    const float bfj = (fr < 8) ? P->b_forget[lj * 8 + fr] : 0.f;
    constexpr int WROW = 2064;
    __syncthreads();
    { const u32x4* src = (const u32x4*)((const bf16_t*)(P->ws + WS_WF) + (size_t)lj * 2 * 16384);
#pragma unroll
      for (int j = 0; j < 8; ++j) { const int i = tid + 512 * j, row = i >> 7, ch = i & 127; *(LAS u32x4*)(lds + row * WROW + ch * 16) = src[i]; } }
    __syncthreads();
    for (int rg = gw; rg < MTOK / 16; rg += NGW) {
        const bf16_t* xa = XB + (size_t)(rg * 16 + fr) * DM + fq * 8;
        bf16x8 av[32];
#pragma unroll
        for (int ks = 0; ks < 32; ++ks) av[ks] = *(const bf16x8*)(xa + ks * 32);
        f32x4 s4[4];
#pragma unroll
        for (int j = 0; j < 4; ++j) s4[j] = *(const f32x4*)(SSQ + (size_t)(rg * 16 + 4 * fq + j) * 4);
        const unsigned wb = (unsigned)(uintptr_t)lds + fr * WROW + fq * 16;
        f32x4v acc = (f32x4v){0.f, 0.f, 0.f, 0.f};
#pragma unroll
        for (int c = 0; c < 8; ++c) {
            bf16x8 bh[4], bl[4];
#pragma unroll
            for (int i = 0; i < 4; ++i) { const int ks = 4 * c + i; bh[i] = *(const LAS bf16x8*)(wb + ks * 64); bl[i] = *(const LAS bf16x8*)(wb + 16 * WROW + ks * 64); }
#pragma unroll
            for (int i = 0; i < 4; ++i) { const int ks = 4 * c + i; acc = __builtin_amdgcn_mfma_f32_16x16x32_bf16(av[ks], bh[i], acc, 0, 0, 0); acc = __builtin_amdgcn_mfma_f32_16x16x32_bf16(av[ks], bl[i], acc, 0, 0, 0); }
            __builtin_amdgcn_sched_barrier(0);
        }
        if (fr < 8) {
#pragma unroll
            for (int j = 0; j < 4; ++j) { const int row = rg * 16 + 4 * fq + j;
                const float rs = 1.0f / sqrtf(((s4[j][0] + s4[j][1]) + (s4[j][2] + s4[j][3])) * (1.0f / 1024.0f) + EPS);
                const float z = acc[j] * rs + bfj; const float lf = fminf(z, 0.f) - log1pf(expf(-fabsf(z)));
                LOGF[((size_t)(row >> 11) * 8 + fr) * SEQ + (row & 2047)] = lf; }
        }
    }
}

__device__ __forceinline__ void glds16(const void* gsrc, unsigned lds_dst) { unsigned keep;
    asm volatile("s_mov_b32 %0, m0\n\ts_mov_b32 m0, %2\n\ts_nop 0\n\tglobal_load_lds_dwordx4 %1, off\n\ts_mov_b32 m0, %0" : "=&s"(keep) : "v"(gsrc), "s"(lds_dst) : "memory"); }
__device__ __forceinline__ float fadd_s(float a, float b) { asm("" : "+v"(b)); return a + b; }
__device__ __forceinline__ int crow(int r, int hi) { return (r & 3) + 8 * (r >> 2) + 4 * hi; }
__device__ __forceinline__ s16x4 vtr(unsigned addr) { typedef short v4i16_t __attribute__((ext_vector_type(4))); return __builtin_bit_cast(s16x4, __builtin_amdgcn_ds_read_tr16_b64_v4i16((LAS v4i16_t*)addr)); }

template <int VAR>
__device__ __forceinline__ void attn_unit(CP P, int lj, int ub, int uh, int uq, ldsp lds) {
    constexpr int DV = (VAR == 2) ? 128 : 64, NDB = DV / 32, NP = (VAR == 2) ? 2 : 1;
#define HM(row, col) ((size_t)((col) >> 6) * HB + (size_t)(row) * 64 + ((col) & 63))
    constexpr int KTB = (VAR == 2) ? 16384 : 8192, VTB = KTB;
    constexpr bool PIPE = (VAR < 2);
    constexpr int GP = DV * 2, GSB = 32 * GP;
    constexpr int DPF = PIPE ? 4 : 2, NS = PIPE ? DPF + 2 : DPF + 1, SLOT = KTB + VTB;
    constexpr int RINGB = (NS * SLOT < 65536) ? 65536 : NS * SLOT;
    constexpr int L_AUX = RINGB, L_WS = L_AUX + 8192, L_G = L_WS + 2048;
    static_assert(L_G + ((VAR == 2) ? 4 : 8) * GSB <= LDS_QW, "attention LDS map");
    const int tid = opaque_tid(), lane = tid & 63, wid = __builtin_amdgcn_readfirstlane(tid >> 6), r32 = lane & 31, hi = lane >> 5;
    const bf16_t* proj = (const bf16_t*)(P->ws + WS_PROJ);
    bf16_t* Y = (bf16_t*)(P->ws + WS_Y);
    const size_t rowb = (size_t)ub * SEQ;
    int colQ, colK, colV, colG, colY, wq0, t_lo, t_hi; float slope2 = 0.f; const float *gqp, *gkp;
    if constexpr (VAR == 0) { colQ = uh * 64; colK = 512 + uh * 64; colV = 1024 + uh * 64; colG = 1536 + uh * 64; colY = uh * 64; wq0 = uq * 256 + wid * 32; t_lo = 0; t_hi = 4 * uq + 4;
        slope2 = exp2f(-(float)(uh + 1)) * LOG2E; gqp = P->moba_q_gain + lj * 64; gkp = P->moba_k_gain + lj * 64; }
    else if constexpr (VAR == 1) { colQ = 2048 + uh * 64; colK = 2560 + uh * 64; colV = 3072 + uh * 64; colG = 3584 + uh * 64; colY = 512 + uh * 64; wq0 = uq * 256 + wid * 32; t_lo = 0; t_hi = 4 * uq + 4;
        gqp = P->fox_q_gain + lj * 64; gkp = P->fox_k_gain + lj * 64; }
    else if constexpr (VAR == 2) { const int c = wid >> 2; colQ = uh * 128 + c * 64; colK = 512 + uh * 128; colV = 1024 + uh * 128; colG = 1536 + uh * 128; colY = uh * 128; wq0 = uq * 128 + ((wid + 2 * c) & 3) * 32; t_lo = 0; t_hi = 2 * uq + 2;
        slope2 = exp2f(-2.0f * (float)(uh + 1)) * LOG2E; gqp = P->diff_q_gain + lj * 64; gkp = P->diff_k_gain + lj * 64; }
    else { const int hq = 4 * uh + ((wid + 2 * (wid >> 2)) & 3); colQ = 2048 + hq * 64;        colK = 2560 + uh * 64; colV = 2688 + uh * 64; colG = 2816 + hq * 64; colY = 512 + hq * 64; wq0 = uq * 64 + (wid >> 2) * 32; t_lo = uq >= 2 ? uq - 2 : 0; t_hi = uq + 1;
        slope2 = exp2f(-(float)(hq + 1)) * LOG2E; gqp = P->swa_q_gain + lj * 64; gkp = P->swa_k_gain + lj * 64; }
    const int t = wq0 + r32;
    const int twmin = wq0, twmax = wq0 + 31;
    const unsigned lds0 = (unsigned)(uintptr_t)lds;
    const int krow = 8 * wid + (lane >> 3);
    const bf16_t* kgd = proj + HM(rowb + krow, colK) + (((lane & 7) ^ ((krow >> 1) & 7)) * 8);
    const bf16_t* vgd = proj + HM(rowb + 16 * (wid & 3) + (lane >> 2), colV) + (wid >> 2) * 32 + (lane & 3) * 8;
    const int n_hi = t_hi - 1;
#define DMA_TILE(j, slot) do { int tj_ = n_hi - (j); tj_ = tj_ < t_lo ? t_lo : tj_; const size_t ro_ = (size_t)tj_ * 64 * 64; const unsigned sl_ = (unsigned)(slot) * SLOT + wid * 1024; \
        _Pragma("unroll") for (int p_ = 0; p_ < NP; ++p_) glds16(kgd + ro_ + p_ * HB, (unsigned)__builtin_amdgcn_readfirstlane((int)(lds0 + sl_ + p_ * 8192))); \
        _Pragma("unroll") for (int p_ = 0; p_ < NP; ++p_) glds16(vgd + ro_ + p_ * HB, (unsigned)__builtin_amdgcn_readfirstlane((int)(lds0 + sl_ + KTB + p_ * 8192))); } while (0)
#pragma unroll
    for (int j = 0; j < 2; ++j) DMA_TILE(j, j);
    bf16x8 qr[4];
    { const bf16_t* qrow = proj + HM(rowb + t, colQ);
#pragma unroll
      for (int d0 = 0; d0 < 4; ++d0) qr[d0] = *(const bf16x8*)(qrow + d0 * 16 + hi * 8); }
    const int dqg = (wid + 2 * (wid >> 2)) & 3;
    const unsigned gbase = lds0 + L_G + ((VAR == 2) ? dqg : wid) * GSB;
    float gqv, gkv;
    float sinkv = 0.f; if constexpr (VAR == 3) sinkv = P->swa_sinks[lj * 8 + 4 * uh + ((wid + 2 * (wid >> 2)) & 3)];
    f32x4 lfv = (f32x4){0.f, 0.f, 0.f, 0.f}; float km0 = 0.f, km1 = 0.f;
    if constexpr (VAR == 1) lfv = *(const f32x4*)((const float*)(P->ws + WS_LOGF) + ((size_t)ub * 8 + uh) * SEQ + 4 * tid);
    if constexpr (VAR == 0) { const float* kp = (const float*)(P->ws + WS_KMEAN); const int n = tid >> 6, d = tid & 63;
        km0 = kp[((size_t)((ub * 8 + n) * 2 + 0) * 8 + uh) * 64 + d]; km1 = kp[((size_t)((ub * 8 + n) * 2 + 1) * 8 + uh) * 64 + d]; }
    { const float gq_ = gqp[lane], gk_ = gkp[lane];
      __builtin_amdgcn_sched_barrier(0);
      gqv = gq_; gkv = gk_; }
    const float M0 = 8.0f * wave_max(fabsf(gqv)) * wave_max(fabsf(gkv)) * LOG2E;
    unsigned sel = 0u; float cst = 0.f;
    if constexpr (VAR == 0) {
        if (uq >= 4) {
            LAS float* km = (LAS float*)(lds + L_AUX);
            if (tid < uq * 64) km[tid] = (km0 + km1) * (1.0f / 256.0f);
            __syncthreads();
            float g[7];
#pragma unroll
            for (int n = 0; n < 7; ++n) { float a = 0.f;
                if (n < uq) {
#pragma unroll
                    for (int d0 = 0; d0 < 4; ++d0) { const f32x4 k0 = *(const LAS f32x4*)(km + n * 64 + d0 * 16 + hi * 8), k1 = *(const LAS f32x4*)(km + n * 64 + d0 * 16 + hi * 8 + 4);
#pragma unroll
                        for (int e = 0; e < 4; ++e) { a += bf2f((unsigned short)qr[d0][e]) * k0[e]; a += bf2f((unsigned short)qr[d0][4 + e]) * k1[e]; } }
                }
                a = xadd32(a); g[n] = a; }
#pragma unroll
            for (int pick = 0; pick < 3; ++pick) { float best = -INFINITY; int bi = -1;
#pragma unroll
                for (int n = 0; n < 7; ++n) { const bool ok = (n < uq) && !((sel >> n) & 1u) && (g[n] > best); best = ok ? g[n] : best; bi = ok ? n : bi; }
                if (bi >= 0) sel |= 1u << bi; }
        } else sel = (1u << uq) - 1u;
        sel |= 1u << uq;
    }
    if constexpr (VAR == 1) {
        LAS float* cs = (LAS float*)(lds + L_AUX); LAS float* wt = (LAS float*)(lds + L_WS);
        f32x4 v = lfv;
        v[1] += v[0]; v[2] += v[1]; v[3] += v[2];
        float incl = v[3];
#pragma unroll
        for (int o = 1; o < 64; o <<= 1) { const float u = __shfl_up(incl, o); if (lane >= o) incl += u; }
        if (lane == 63) wt[wid] = incl;
        __syncthreads();
        float woff = 0.f;
#pragma unroll
        for (int w = 0; w < 8; ++w) woff += (w < wid) ? wt[w] : 0.f;
        const float ex = incl - v[3] + woff;
        *(LAS f32x4*)(cs + 4 * tid) = (f32x4){(ex + v[0]) * LOG2E, (ex + v[1]) * LOG2E, (ex + v[2]) * LOG2E, (ex + v[3]) * LOG2E};
        __syncthreads();
        cst = cs[t] - M0;
    }
    const float TH = 2.0f * M0 + 27.0f;
    float THw = TH;
    bool have_m = false;
    int t_first = t_lo; float dmax = 1e30f; float cs_wmin = 0.f;
    if constexpr (VAR == 0 || VAR == 2) {
        dmax = TH / slope2;
        const int t_umin = (VAR == 0) ? uq * 256 : uq * 128;
        const float f = ((float)t_umin - dmax - 63.0f) * (1.0f / 64.0f);
        if (f > (float)t_lo) { const int c = (int)ceilf(f); t_first = c < t_hi - 1 ? c : t_hi - 1; }
    }
    if constexpr (VAR == 1) {
        const LAS float* cs = (const LAS float*)(lds + L_AUX);
        const float cu = cs[uq * 256];
        { const int ti_ = lane & 31; const bool keep_ = (ti_ >= t_hi - 1) || ((cu - cs[ti_ * 64 + 63]) >= -TH);
          t_first = __builtin_amdgcn_readfirstlane(__builtin_ctzll(__ballot(keep_) | (1ull << 31))); }
        cs_wmin = cs[twmin];
    }
    int tw_first = 0;
#define FOX_FIRST() do { if constexpr (VAR == 1) { const int ti_ = lane & 31; const bool keep_ = (ti_ * 64 + 63 >= twmin) || ((cs_wmin - ((const LAS float*)(lds + L_AUX))[ti_ * 64 + 63]) >= -THw); \
        const unsigned long long bm_ = __ballot(keep_); tw_first = __builtin_amdgcn_readfirstlane(__builtin_ctzll(bm_ | (1ull << 31))); } } while (0)
    FOX_FIRST();
    const int n = t_hi - t_first;
    unsigned kro[4];
#pragma unroll
    for (int d0 = 0; d0 < 4; ++d0) { const int ch = 2 * d0 + hi; kro[d0] = lds0 + ((VAR == 2) ? (wid >> 2) * 8192 : 0) + r32 * 128 + ((ch ^ ((r32 >> 1) & 7)) << 4); }
    const unsigned vro = lds0 + KTB + ((lane >> 4) & 1) * 32 + (lane & 3) * 8 + (4 * hi + ((lane & 15) >> 2)) * 64;
    f32x16 o[NDB];
#pragma unroll
    for (int db = 0; db < NDB; ++db) o[db] = (f32x16){};
    float lsum = 0.f;
#define ACT(tt, out) do { const int kv0_ = (tt) * 64; bool a_ = kv0_ <= twmax; \
        if constexpr (VAR == 0 || VAR == 2) a_ = a_ && ((float)(twmin - (kv0_ + 63)) * slope2 <= THw); \
        if constexpr (VAR == 1) a_ = a_ && ((tt) >= tw_first); \
        out = a_; } while (0)
#define QK_STEP(tt, kb, P0, P1) do { const int kv0_ = (tt) * 64; bf16x8 kf[8]; \
        _Pragma("unroll") for (int d0 = 0; d0 < 4; ++d0) { kf[2 * d0] = *(const LAS bf16x8*)(kro[d0] + (kb) * SLOT); kf[2 * d0 + 1] = *(const LAS bf16x8*)(kro[d0] + (kb) * SLOT + 4096); } \
        if constexpr (VAR == 1) { const LAS float* cs_ = (const LAS float*)(lds + L_AUX) + kv0_ + 4 * hi; f32x4 c0[4], c1[4]; \
            _Pragma("unroll") for (int g4 = 0; g4 < 4; ++g4) { c0[g4] = *(const LAS f32x4*)(cs_ + 8 * g4); c1[g4] = *(const LAS f32x4*)(cs_ + 32 + 8 * g4); } \
            __builtin_amdgcn_sched_barrier(0);        \
            _Pragma("unroll") for (int g4 = 0; g4 < 4; ++g4) { _Pragma("unroll") for (int e = 0; e < 4; ++e) { P0[4 * g4 + e] = cst - c0[g4][e]; P1[4 * g4 + e] = cst - c1[g4][e]; } } \
        } else { __builtin_amdgcn_sched_barrier(0); float base = slope2 * (float)(kv0_ + 4 * hi - t) - M0; \
            if constexpr (VAR == 0) { if (!((sel >> ((tt) >> 2)) & 1u)) base = -1e30f; } \
            _Pragma("unroll") for (int r = 0; r < 16; ++r) { P0[r] = fmaf(slope2, (float)(8 * (r >> 2) + (r & 3)), base); P1[r] = fmaf(slope2, (float)(32 + 8 * (r >> 2) + (r & 3)), base); } } \
        _Pragma("unroll") for (int d0 = 0; d0 < 4; ++d0) { P0 = __builtin_amdgcn_mfma_f32_32x32x16_bf16(kf[2 * d0], qr[d0], P0, 0, 0, 0); P1 = __builtin_amdgcn_mfma_f32_32x32x16_bf16(kf[2 * d0 + 1], qr[d0], P1, 0, 0, 0); } \
    } while (0)
#define SM_STEP(tt, vb, P0, P1) do { const int kv0_ = (tt) * 64; \
        if (kv0_ + 63 > twmin) { _Pragma("unroll") for (int r = 0; r < 16; ++r) { const int kv = kv0_ + crow(r, hi); if (kv > t) P0[r] = -INFINITY; if (kv + 32 > t) P1[r] = -INFINITY; } } \
        if constexpr (VAR == 3) { if (kv0_ <= twmax - 128) { _Pragma("unroll") for (int r = 0; r < 16; ++r) { const int kv = kv0_ + crow(r, hi); if (kv <= t - 128) P0[r] = -INFINITY; if (kv + 32 <= t - 128) P1[r] = -INFINITY; } } } \
        if constexpr (VAR != 3) { if (!have_m) { float m_ = fmaxf(P0[0], P1[0]); _Pragma("unroll") for (int r = 1; r < 16; ++r) m_ = fmaxf(m_, fmaxf(P0[r], P1[r])); \
            m_ = xmax32(m_); m_ = rmin16(m_); m_ = xmin16(m_); \
            if (m_ > -1e20f) { THw = fminf(THw, 27.0f - m_); have_m = true; FOX_FIRST(); } } } \
          \
        float lacc_ = 0.f; u32x4 pwc_, pwn_ = (u32x4){0u, 0u, 0u, 0u}; s16x4 vl[NDB], vh[NDB]; \
        _Pragma("unroll") for (int e_ = 0; e_ < 8; ++e_) { P0[e_] = __builtin_amdgcn_exp2f(P0[e_]); lacc_ += P0[e_]; } \
        pwc_ = (u32x4){pk_bf16(P0[0], P0[1]), pk_bf16(P0[2], P0[3]), pk_bf16(P0[4], P0[5]), pk_bf16(P0[6], P0[7])}; \
        _Pragma("unroll") for (int ks_ = 0; ks_ < 4; ++ks_) { \
            _Pragma("unroll") for (int db = 0; db < NDB; ++db) { vl[db] = vtr(vro + (vb) * SLOT + db * 4096 + ks_ * 1024); vh[db] = vtr(vro + (vb) * SLOT + db * 4096 + ks_ * 1024 + 512); } \
            _Pragma("unroll") for (int db = 0; db < NDB; ++db) { \
                const bf16x8 vf = (bf16x8){vl[db][0], vl[db][1], vl[db][2], vl[db][3], vh[db][0], vh[db][1], vh[db][2], vh[db][3]}; \
                o[db] = __builtin_amdgcn_mfma_f32_32x32x16_bf16(__builtin_bit_cast(bf16x8, pwc_), vf, o[db], 0, 0, 0); \
                if (ks_ < 3) { constexpr int EPG = 8 / NDB;   \
                    _Pragma("unroll") for (int j_ = 0; j_ < EPG; ++j_) { const int e_ = 8 * ((ks_ + 1) & 1) + db * EPG + j_; \
                        if (ks_ + 1 < 2) { P0[e_] = __builtin_amdgcn_exp2f(P0[e_]); lacc_ += P0[e_]; } else { P1[e_] = __builtin_amdgcn_exp2f(P1[e_]); lacc_ += P1[e_]; } } \
                    if (EPG == 2) { const int e_ = 8 * ((ks_ + 1) & 1) + db * 2; pwn_[db] = (ks_ + 1 < 2) ? pk_bf16(P0[e_], P0[e_ + 1]) : pk_bf16(P1[e_], P1[e_ + 1]); } \
                    else { const int e_ = 8 * ((ks_ + 1) & 1) + db * 4; pwn_[2 * db] = (ks_ + 1 < 2) ? pk_bf16(P0[e_], P0[e_ + 1]) : pk_bf16(P1[e_], P1[e_ + 1]); pwn_[2 * db + 1] = (ks_ + 1 < 2) ? pk_bf16(P0[e_ + 2], P0[e_ + 3]) : pk_bf16(P1[e_ + 2], P1[e_ + 3]); } \
                    asm volatile("" : "+v"(lacc_), "+v"(pwn_)); } \
                __builtin_amdgcn_sched_barrier(0); } \
            pwc_ = pwn_; } \
        lsum += lacc_; \
    } while (0)
#define WAITBAR(N) asm volatile("s_waitcnt vmcnt(" #N ") lgkmcnt(0)\n\ts_barrier" ::: "memory")
#define ITER(ii, PA0, PA1, PB0, PB1) do { const int it_ = (ii), tt_ = n_hi - it_, bcur_ = sc, bnxt_ = (sc + 1 == NS) ? 0 : sc + 1; bool a0_, a1_ = false; ACT(tt_, a0_); \
        DMA_TILE(it_ + DPF, (sc == 0) ? NS - 1 : sc - 1); sc = bnxt_; \
        (void)a1_; (void)bnxt_; if (a0_) { QK_STEP(tt_, bcur_, PA0, PA1); SM_STEP(tt_, bcur_, PA0, PA1); } \
        if constexpr (NP == 2) WAITBAR(4); else WAITBAR(2); } while (0)
#define SB() __builtin_amdgcn_sched_barrier(0)
#define KLOAD2(d0, sl) do { kf[2 * (d0)] = *(const LAS bf16x8*)(kro[d0] + (sl) * SLOT); kf[2 * (d0) + 1] = *(const LAS bf16x8*)(kro[d0] + (sl) * SLOT + 4096); } while (0)
#define CINIT(tt, C0, C1) do { const int kv0_ = (tt) * 64; \
        if constexpr (VAR == 1) { const LAS float* cs_ = (const LAS float*)(lds + L_AUX) + kv0_ + 4 * hi; f32x4 c0[4]; \
            _Pragma("unroll") for (int g4 = 0; g4 < 4; ++g4) c0[g4] = *(const LAS f32x4*)(cs_ + 8 * g4); \
            SB(); \
            _Pragma("unroll") for (int g4 = 0; g4 < 4; ++g4) { _Pragma("unroll") for (int e = 0; e < 4; ++e) C0[4 * g4 + e] = cst - c0[g4][e]; } \
            _Pragma("unroll") for (int g4 = 0; g4 < 4; ++g4) c0[g4] = *(const LAS f32x4*)(cs_ + 32 + 8 * g4); \
            SB(); \
            _Pragma("unroll") for (int g4 = 0; g4 < 4; ++g4) { _Pragma("unroll") for (int e = 0; e < 4; ++e) C1[4 * g4 + e] = cst - c0[g4][e]; } \
        } else { float base = slope2 * (float)(kv0_ + 4 * hi - t) - M0; \
            if constexpr (VAR == 0) { if (!((sel >> ((tt) >> 2)) & 1u)) base = -1e30f; } \
            _Pragma("unroll") for (int r = 0; r < 16; ++r) { C0[r] = fmaf(slope2, (float)(8 * (r >> 2) + (r & 3)), base); C1[r] = fmaf(slope2, (float)(32 + 8 * (r >> 2) + (r & 3)), base); } } } while (0)
#define MASKM(tt, C0, C1) do { const int kv0_ = (tt) * 64; \
        if (kv0_ + 63 > twmin) { _Pragma("unroll") for (int r = 0; r < 16; ++r) { const int kv = kv0_ + crow(r, hi); if (kv > t) C0[r] = -INFINITY; if (kv + 32 > t) C1[r] = -INFINITY; } } \
        if constexpr (VAR == 3) { if (kv0_ <= twmax - 128) { _Pragma("unroll") for (int r = 0; r < 16; ++r) { const int kv = kv0_ + crow(r, hi); if (kv <= t - 128) C0[r] = -INFINITY; if (kv + 32 <= t - 128) C1[r] = -INFINITY; } } } \
        if constexpr (VAR != 3) { if (!have_m) { float m_ = fmaxf(C0[0], C1[0]); _Pragma("unroll") for (int r = 1; r < 16; ++r) m_ = fmaxf(m_, fmaxf(C0[r], C1[r])); \
            m_ = xmax32(m_); m_ = rmin16(m_); m_ = xmin16(m_); \
            if (m_ > -1e20f) { THw = fminf(THw, 27.0f - m_); have_m = true; FOX_FIRST(); } } } } while (0)
#define VRD(i, sl) do { vl[(i) & 3] = vtr(vro + (sl) * SLOT + ((i) >> 2) * 4096 + ((i) & 3) * 1024); vh[(i) & 3] = vtr(vro + (sl) * SLOT + ((i) >> 2) * 4096 + ((i) & 3) * 1024 + 512); } while (0)
#define VFR(i) ((bf16x8){vl[(i) & 3][0], vl[(i) & 3][1], vl[(i) & 3][2], vl[(i) & 3][3], vh[(i) & 3][0], vh[(i) & 3][1], vh[(i) & 3][2], vh[(i) & 3][3]})
#define PEL(P0, P1, k, j) (((k) < 4) ? P0[4 * ((k) & 3) + (j)] : P1[4 * ((k) & 3) + (j)])
#define QKM(k, C0, C1) do { if (((k) & 1) == 0) C0 = __builtin_amdgcn_mfma_f32_32x32x16_bf16(kf[k], qr[(k) >> 1], C0, 0, 0, 0); else C1 = __builtin_amdgcn_mfma_f32_32x32x16_bf16(kf[k], qr[(k) >> 1], C1, 0, 0, 0); } while (0)
#define SUMCVT4(k, P0, P1) do { lacc += PEL(P0, P1, k, 0); lacc += PEL(P0, P1, k, 1); lacc += PEL(P0, P1, k, 2); lacc += PEL(P0, P1, k, 3); \
        pw[(k) >> 1][((k) & 1) * 2] = pk_bf16(PEL(P0, P1, k, 0), PEL(P0, P1, k, 1)); pw[(k) >> 1][((k) & 1) * 2 + 1] = pk_bf16(PEL(P0, P1, k, 2), PEL(P0, P1, k, 3)); } while (0)
#define EXP4(k, C0, C1) do { _Pragma("unroll") for (int j_ = 0; j_ < 4; ++j_) { if ((k) < 4) C0[4 * ((k) & 3) + j_] = __builtin_amdgcn_exp2f(C0[4 * ((k) & 3) + j_]); else C1[4 * ((k) & 3) + j_] = __builtin_amdgcn_exp2f(C1[4 * ((k) & 3) + j_]); } } while (0)
#define PVM(k) do { o[(k) >> 2] = __builtin_amdgcn_mfma_f32_32x32x16_bf16(__builtin_bit_cast(bf16x8, pw[(k) & 3]), VFR(k), o[(k) >> 2], 0, 0, 0); } while (0)
#define PINV(x) asm volatile("" : "+v"(x))
#define GAPA(k, C0, C1, P0, P1, slv) do { if ((k) >= 4) VRD((k) - 4, slv); QKM(k, C0, C1); SUMCVT4(k, P0, P1); PINV(lacc); PINV(pw[(k) >> 1]); SB(); } while (0)
#define GAPB(k, C0, C1, slk, slv, dok) do { if ((k) >= 2 && (k) <= 5) KLOAD2((k) - 2, slk); PVM(k); if ((k) < 4) VRD((k) + 4, slv); EXP4(k, C0, C1); if ((k) < 4) PINV(C0); else PINV(C1); SB(); } while (0)
#define STEP(tstep, C0, C1, Pp0, Pp1) do { const int ts_ = (tstep), tt_ = n_hi - ts_; const int slc_ = sc, slp_ = (sc == 0) ? NS - 1 : sc - 1, sln_ = (sc + 1 == NS) ? 0 : sc + 1; \
        DMA_TILE(ts_ + DPF, (slp_ == 0) ? NS - 1 : slp_ - 1); sc = sln_; \
        bool a_next = false; if (ts_ + 1 < n) ACT(tt_ - 1, a_next); \
        const bool a_c = (ts_ < n) && a_cur; \
        if (a_c && a_prev) { \
            float lacc = 0.f; s16x4 vl[4], vh[4]; \
            CINIT(tt_, C0, C1); SB(); \
            GAPA(0, C0, C1, Pp0, Pp1, slp_); GAPA(1, C0, C1, Pp0, Pp1, slp_); GAPA(2, C0, C1, Pp0, Pp1, slp_); GAPA(3, C0, C1, Pp0, Pp1, slp_); \
            GAPA(4, C0, C1, Pp0, Pp1, slp_); GAPA(5, C0, C1, Pp0, Pp1, slp_); GAPA(6, C0, C1, Pp0, Pp1, slp_); GAPA(7, C0, C1, Pp0, Pp1, slp_); \
            lsum += lacc; MASKM(tt_, C0, C1); SB(); \
            GAPB(0, C0, C1, sln_, slp_, a_next); GAPB(1, C0, C1, sln_, slp_, a_next); GAPB(2, C0, C1, sln_, slp_, a_next); GAPB(3, C0, C1, sln_, slp_, a_next); \
            GAPB(4, C0, C1, sln_, slp_, a_next); GAPB(5, C0, C1, sln_, slp_, a_next); GAPB(6, C0, C1, sln_, slp_, a_next); GAPB(7, C0, C1, sln_, slp_, a_next); \
        } else { \
            if (a_c) { CINIT(tt_, C0, C1); SB(); _Pragma("unroll") for (int k_ = 0; k_ < 8; k_ += 2) { C0 = __builtin_amdgcn_mfma_f32_32x32x16_bf16(kf[k_], qr[k_ >> 1], C0, 0, 0, 0); C1 = __builtin_amdgcn_mfma_f32_32x32x16_bf16(kf[k_ + 1], qr[k_ >> 1], C1, 0, 0, 0); } } \
            if (a_prev) { float lacc = 0.f; s16x4 vl[4], vh[4]; VRD(0, slp_); VRD(1, slp_); VRD(2, slp_); VRD(3, slp_); \
                SUMCVT4(0, Pp0, Pp1); SUMCVT4(1, Pp0, Pp1); SUMCVT4(2, Pp0, Pp1); SUMCVT4(3, Pp0, Pp1); SUMCVT4(4, Pp0, Pp1); SUMCVT4(5, Pp0, Pp1); SUMCVT4(6, Pp0, Pp1); SUMCVT4(7, Pp0, Pp1); lsum += lacc; \
                PVM(0); PVM(1); PVM(2); PVM(3); VRD(4, slp_); VRD(5, slp_); VRD(6, slp_); VRD(7, slp_); PVM(4); PVM(5); PVM(6); PVM(7); } \
            if (a_c) { MASKM(tt_, C0, C1); EXP4(0, C0, C1); EXP4(1, C0, C1); EXP4(2, C0, C1); EXP4(3, C0, C1); EXP4(4, C0, C1); EXP4(5, C0, C1); EXP4(6, C0, C1); EXP4(7, C0, C1); } \
            if (a_next) { KLOAD2(0, sln_); KLOAD2(1, sln_); KLOAD2(2, sln_); KLOAD2(3, sln_); } \
        } \
        a_prev = a_c; a_cur = a_next; \
        asm volatile("s_waitcnt vmcnt(5) lgkmcnt(0)\n\ts_barrier" ::: "memory"); } while (0)
    asm volatile("" : "+v"(qr[0]), "+v"(qr[1]), "+v"(qr[2]), "+v"(qr[3]));
    asm volatile("s_waitcnt vmcnt(0) lgkmcnt(0)\n\ts_barrier" ::: "memory");
    if constexpr (PIPE) { DMA_TILE(2, 2); DMA_TILE(3, 3); }
    if (VAR != 2 || !(wid >> 2)) { constexpr int CPR = DV / 8, NG = 32 * CPR / 64;
#pragma unroll
        for (int i = 0; i < NG; ++i) { const int idx = i * 64 + lane, row = idx / CPR, ch = idx % CPR;
            glds16(proj + HM(rowb + wq0 + row, colG + ch * 8), (unsigned)__builtin_amdgcn_readfirstlane((int)(gbase + i * 1024))); } }
    f32x16 pa0, pa1, pb0, pb1; int sc = 0;
    if constexpr (PIPE) {
        bf16x8 kf[8]; u32x4 pw[4]; bool a_prev = false, a_cur;
        ACT(n_hi, a_cur);
        if (a_cur) { KLOAD2(0, 0); KLOAD2(1, 0); KLOAD2(2, 0); KLOAD2(3, 0); }
        for (int ts = 0; ts <= n; ts += 2) {
            STEP(ts, pa0, pa1, pb0, pb1);
            if (ts + 1 <= n) STEP(ts + 1, pb0, pb1, pa0, pa1);
        }
    } else {
        for (int i = 0; i < n; ++i) ITER(i, pa0, pa1, pb0, pb1);
    }
    asm volatile("s_waitcnt vmcnt(0) lgkmcnt(0)\n\ts_barrier" ::: "memory");
#undef DMA_TILE
#undef WAITBAR
#undef FOX_FIRST
#undef ACT
#undef QK_STEP
#undef SM_STEP
#undef ITER
#undef STEP
#undef GAPA
#undef PINV
#undef GAPB
#undef PVM
#undef EXP4
#undef SUMCVT4
#undef QKM
#undef PEL
#undef VFR
#undef VRD
#undef MASKM
#undef CINIT
#undef KLOAD2
#undef SB
    lsum = xadd32(lsum);
    if constexpr (VAR == 3) lsum += exp2f(sinkv * LOG2E - M0);
    LAS float* wsf = (LAS float*)(lds + L_WS) + wid * 64;
    if (hi == 0) wsf[r32] = 1.0f / lsum;
    asm volatile("s_waitcnt lgkmcnt(0)" ::: "memory");
    float rli[16];
#pragma unroll
    for (int r = 0; r < 16; ++r) rli[r] = wsf[crow(r, hi)];
#define OUT_ROWS(ost, NCH) do { asm volatile("s_waitcnt lgkmcnt(0)" ::: "memory"); \
        _Pragma("unroll") for (int i_ = 0; i_ < 32 * (NCH) / 64; ++i_) { const int idx_ = i_ * 64 + lane, row_ = idx_ / (NCH), ch_ = idx_ % (NCH); \
            const f32x4 a_ = *(const LAS f32x4*)((ost) + row_ * DV + ch_ * 8), b_ = *(const LAS f32x4*)((ost) + row_ * DV + ch_ * 8 + 4); \
            const u32x4 g_ = *(const LAS u32x4*)(gbase + row_ * GP + ch_ * 16); u32x4 w_; \
            w_.x = pk_bf16(a_[0] * __uint_as_float(g_.x << 16), a_[1] * __uint_as_float(g_.x & 0xffff0000u)); w_.y = pk_bf16(a_[2] * __uint_as_float(g_.y << 16), a_[3] * __uint_as_float(g_.y & 0xffff0000u)); \
            w_.z = pk_bf16(b_[0] * __uint_as_float(g_.z << 16), b_[1] * __uint_as_float(g_.z & 0xffff0000u)); w_.w = pk_bf16(b_[2] * __uint_as_float(g_.w << 16), b_[3] * __uint_as_float(g_.w & 0xffff0000u)); \
            *(u32x4*)(Y + (rowb + wq0 + row_) * DM + colY + ch_ * 8) = w_; } } while (0)
    if constexpr (VAR != 2) {
        LAS float* ost = (LAS float*)lds + wid * 2048;
#pragma unroll
        for (int r = 0; r < 16; ++r)
#pragma unroll
            for (int db = 0; db < NDB; ++db) ost[crow(r, hi) * DV + db * 32 + r32] = o[db][r] * rli[r];
        OUT_ROWS(ost, 8);
        __syncthreads();
    } else {
        int ljo = lj; asm volatile("" : "+s"(ljo));
        const float* lp = P->diff_lambda + ljo * 256; const int layer = 2 * ljo + 1;
        const float lam_init = 0.8f - 0.6f * expf(-0.3f * (float)layer);
        const float lam = expf(wave_sum(lp[lane] * lp[64 + lane])) - expf(wave_sum(lp[128 + lane] * lp[192 + lane])) + lam_init;
        LAS float* ex = (LAS float*)lds + dqg * 4096;
        if (wid >> 2) {
#pragma unroll
            for (int db = 0; db < NDB; ++db)
#pragma unroll
                for (int r = 0; r < 16; ++r) ex[(db * 16 + r) * 64 + lane] = o[db][r] * rli[r];
        }
        __syncthreads();
        if (!(wid >> 2)) {
            float ss[16];
#pragma unroll
            for (int r = 0; r < 16; ++r) { float a = 0.f;
#pragma unroll
                for (int db = 0; db < NDB; ++db) { const float v = o[db][r] * rli[r] - lam * ex[(db * 16 + r) * 64 + lane]; o[db][r] = v; a += v * v; }
                a = rsum16(a); a = xadd16(a);
                ss[r] = __builtin_amdgcn_rsqf(a * (1.0f / 128.0f) + EPS) * (1.0f - lam_init); }
            float sg[NDB];
#pragma unroll
            for (int db = 0; db < NDB; ++db) sg[db] = P->diff_subln_gain[lj * 128 + db * 32 + r32];
            asm volatile("s_waitcnt lgkmcnt(0)" ::: "memory");
            LAS float* ost = ex;
#pragma unroll
            for (int r = 0; r < 16; ++r)
#pragma unroll
                for (int db = 0; db < NDB; ++db) ost[crow(r, hi) * DV + db * 32 + r32] = o[db][r] * ss[r] * sg[db];
            OUT_ROWS(ost, 16);
        }
        __syncthreads();
    }
#undef OUT_ROWS
}

__device__ __forceinline__ void phase_attn(CP P, int layer, ldsp lds, unsigned* ctr) {
    const int tid = opaque_tid(); const int lj = layer >> 1;
    volatile LAS unsigned* qw = (volatile LAS unsigned*)(lds + LDS_QW);
    const unsigned G = gridDim.x;
    unsigned nxt = blockIdx.x;
    if (tid == 0) qw[8] = 0u;
    for (;;) {
        if (tid == 0) *qw = nxt;
        __syncthreads();
        const unsigned u = *qw;
        __syncthreads();
        unsigned ua = u;
        if (layer == 0) {
            if (u >= 2048u + CONV_TICKETS) break;
            if (u < 9u * CONV_TICKETS) { if (u % 9u == 8u) ua = 0xffffffffu; else ua = u - (u + 1u) / 9u; } else ua = u - CONV_TICKETS;
        } else if (u >= 2048u) break;
        const bool pre = true;
        if (pre && tid == 0) nxt = atomicAdd(ctr, 1u) + G;
        if (ua == 0xffffffffu) {
            const int tc = opaque_tid(), lane = tc & 63, wid = __builtin_amdgcn_readfirstlane(tc >> 6); LAS float* scr = (LAS float*)(lds + wid * 16384);
            CP Pc = P; asm volatile("" : "+s"(Pc));
            const int it0 = I_AB + __builtin_amdgcn_readfirstlane((int)(u / 9u)) * 32 + wid * 4;
#pragma nounroll
            for (int j = 0; j < 4; ++j) convert_item(Pc, it0 + j, scr, lane);
        } else if (!(layer & 1)) { const int qb = 7 - (int)(ua >> 8), r = ua & 255, kind = r >> 7, b = (r >> 3) & 15, h = r & 7;
            if (kind == 0) { if (EN & 16) attn_unit<0>(P, lj, b, h, qb, lds); } else { if (EN & 32) attn_unit<1>(P, lj, b, h, qb, lds); } }
        else { if (u < 1024u) { const int qb = 15 - (int)(u >> 6), r = u & 63; if (EN & 64) attn_unit<2>(P, lj, r >> 2, r & 3, qb, lds); }
            else { if (qw[8] == 0u) {
                    if (tid == 0) { unsigned sp_ = 0; while (__hip_atomic_load(ctr + 32, __ATOMIC_RELAXED, __HIP_MEMORY_SCOPE_AGENT) < (unsigned)(MTOK / 256)) { __builtin_amdgcn_s_sleep(2); if (++sp_ > (1u << 22)) break; }
                        __builtin_amdgcn_fence(__ATOMIC_ACQUIRE, "agent"); asm volatile("s_waitcnt vmcnt(0)" ::: "memory"); }
                    __syncthreads(); if (tid == 0) qw[8] = 1u; }
              const unsigned v = u - 1024u; const int qb = 31 - (int)(v >> 5), r = v & 31; if (EN & 128) attn_unit<3>(P, lj, r >> 1, r & 1, qb, lds); } }
        if (!pre && tid == 0) nxt = atomicAdd(ctr, 1u) + G;
    }
}

#define XB_TMO      128
#define XB_XCNT(j)  (256  + 64 * (j))
#define XB_XSUB(j)  (1280 + 64 * (j))
#define XB_XGEN(j)  (2304 + 64 * (j))
#define XB_TOP      3328
#define XB_TOPGEN   3392
#define XCD_BAR_WORDS 3456
#define XB_SPIN_CAP (1u << 18)

__device__ __forceinline__ unsigned xb_ld(unsigned* p)              { return __hip_atomic_load(p, __ATOMIC_RELAXED, __HIP_MEMORY_SCOPE_AGENT); }
__device__ __forceinline__ unsigned xb_add(unsigned* p, unsigned v) { return __hip_atomic_fetch_add(p, v, __ATOMIC_RELAXED, __HIP_MEMORY_SCOPE_AGENT); }
__device__ __forceinline__ unsigned xb_xcc_id() { return (unsigned)__builtin_amdgcn_s_getreg((3 << 11) | 20) & 0xFu; }
#define XB_SPIN(cond, bar) do { unsigned _sp = 0; while (cond) { __builtin_amdgcn_s_sleep(1); \
    if ((++_sp & 255u) == 0u) { if (xb_ld(&(bar)[XB_TMO])) break; if (_sp > XB_SPIN_CAP) { atomicAdd(&(bar)[XB_TMO], 1u); break; } } } } while (0)

struct XcdBarrier {
    unsigned* bar; unsigned x;
    volatile LAS unsigned* st;
};

__device__ __forceinline__ XcdBarrier xcd_barrier_post(unsigned* bar, volatile LAS unsigned* st) {
    XcdBarrier b; b.bar = bar; b.x = xb_xcc_id(); b.st = st;
    if (threadIdx.x == 0) (void)xb_add(&bar[XB_XCNT(b.x)], 1u);
    return b;
}
__device__ __forceinline__ void xcd_barrier_complete(unsigned* bar, unsigned x, unsigned& nloc, unsigned& nx) {
    const unsigned G = gridDim.x * gridDim.y * gridDim.z;
    unsigned sum, cnt, mine, sp = 0u;
    for (;;) {
        sum = 0u; cnt = 0u; mine = 0u;
        unsigned cj[16]; { const unsigned* mid = &bar[XB_XCNT(8)];
          asm volatile("global_load_dword %0, %16, off offset:-2048 sc1\n\tglobal_load_dword %1, %16, off offset:-1792 sc1\n\tglobal_load_dword %2, %16, off offset:-1536 sc1\n\tglobal_load_dword %3, %16, off offset:-1280 sc1\n\t"
                       "global_load_dword %4, %16, off offset:-1024 sc1\n\tglobal_load_dword %5, %16, off offset:-768 sc1\n\tglobal_load_dword %6, %16, off offset:-512 sc1\n\tglobal_load_dword %7, %16, off offset:-256 sc1\n\t"
                       "global_load_dword %8, %16, off sc1\n\tglobal_load_dword %9, %16, off offset:256 sc1\n\tglobal_load_dword %10, %16, off offset:512 sc1\n\tglobal_load_dword %11, %16, off offset:768 sc1\n\t"
                       "global_load_dword %12, %16, off offset:1024 sc1\n\tglobal_load_dword %13, %16, off offset:1280 sc1\n\tglobal_load_dword %14, %16, off offset:1536 sc1\n\tglobal_load_dword %15, %16, off offset:1792 sc1\n\t"
                       "s_waitcnt vmcnt(0)"
                       : "=&v"(cj[0]), "=&v"(cj[1]), "=&v"(cj[2]), "=&v"(cj[3]), "=&v"(cj[4]), "=&v"(cj[5]), "=&v"(cj[6]), "=&v"(cj[7]),
                         "=&v"(cj[8]), "=&v"(cj[9]), "=&v"(cj[10]), "=&v"(cj[11]), "=&v"(cj[12]), "=&v"(cj[13]), "=&v"(cj[14]), "=&v"(cj[15])
                       : "v"(mid) : "memory"); }
#pragma unroll
        for (unsigned j = 0; j < 16; ++j) { const unsigned c = cj[j]; sum += c; cnt += (c > 0u) ? 1u : 0u; mine = (j == x) ? c : mine; }
        if (sum == G) break;
        __builtin_amdgcn_s_sleep(1);
        if ((++sp & 255u) == 0u) { if (xb_ld(&bar[XB_TMO])) break; if (sp > XB_SPIN_CAP) { atomicAdd(&bar[XB_TMO], 1u); break; } }
    }
    nloc = mine > 0u ? mine : 1u; nx = cnt > 0u ? cnt : 1u;
}

__device__ __forceinline__ void xcd_barrier(const XcdBarrier& b) {
    asm volatile("s_waitcnt vmcnt(0)" ::: "memory");
    __syncthreads();
    if (threadIdx.x == 0) {
        unsigned* bar = b.bar;
        __builtin_amdgcn_s_waitcnt(0);
        unsigned nloc = b.st[0], nx = b.st[1];
        if (nloc == 0u) { xcd_barrier_complete(bar, b.x, nloc, nx); b.st[0] = nloc; b.st[1] = nx; }
        const unsigned old = xb_add(&bar[XB_XSUB(b.x)], 1u);
        const unsigned gen = old / nloc;
        if (old + 1u == (gen + 1u) * nloc) {
            __builtin_amdgcn_fence(__ATOMIC_RELEASE, "agent");
            asm volatile("s_waitcnt vmcnt(0)" ::: "memory");
            const unsigned og = xb_add(&bar[XB_TOP], 1u);
            const unsigned tg = og / nx;
            if (og + 1u == (tg + 1u) * nx) xb_add(&bar[XB_TOPGEN], 1u);
            else XB_SPIN(xb_ld(&bar[XB_TOPGEN]) == tg, bar);
            __builtin_amdgcn_fence(__ATOMIC_ACQUIRE, "agent");
            xb_add(&bar[XB_XGEN(b.x)], 1u);
            asm volatile("s_waitcnt vmcnt(0)" ::: "memory");
        } else {
            XB_SPIN(xb_ld(&bar[XB_XGEN(b.x)]) == gen, bar);
            __builtin_amdgcn_fence(__ATOMIC_ACQUIRE, "agent");
            asm volatile("s_waitcnt vmcnt(0)" ::: "memory");
        }
    }
    __syncthreads();
}


#ifndef MK_N_LAUNCHES
#define MK_N_LAUNCHES 1
#endif
__global__ void __launch_bounds__(512, 2) mega_fwd(Params Pv) {
    CP P = (CP)__builtin_amdgcn_kernarg_segment_ptr(); (void)Pv;
    extern __shared__ __attribute__((aligned(16))) unsigned char lds_raw[];
    ldsp lds = (ldsp)lds_raw;
    cg::grid_group grid = cg::this_grid();
    unsigned* ctl = (unsigned*)(P->ws + WS_CTL);
    volatile LAS unsigned* bst = (volatile LAS unsigned*)(lds + LDS_QW + 16);
    if (threadIdx.x < 2) bst[threadIdx.x] = 0u;
    __syncthreads();
#if MK_N_LAUNCHES == 1
    for (unsigned i = blockIdx.x * 512u + threadIdx.x; i < CTL_ZERO_BYTES / 4; i += gridDim.x * 512u) ctl[i] = 0u;
    grid.sync();
#endif
    XcdBarrier bar = xcd_barrier_post(ctl + 4096, bst);
    const int ph_lo = P->ph_lo, ph_hi = P->ph_hi;
    for (int ph = ph_lo; ph < ph_hi; ++ph) {
        asm volatile("" : "+s"(P));
        if (ph == 0) { if (EN & 1) phase_prologue(P, lds); }
        else {
            const int layer = (ph - 1) / 3, sub = (ph - 1) % 3, lj = layer >> 1, cd = layer & 1;
            if (sub == 0 || (sub == 1 && cd)) {
                pg8::Gemm g{(const bf16_t*)(P->ws + WS_XB), cd ? (const bf16_t*)(P->ws + WS_WT_CD) + (size_t)lj * CD_N * 1024 : (const bf16_t*)(P->ws + WS_WT_AB) + (size_t)lj * AB_N * 1024, MTOK, cd ? CD_N : AB_N, DM};
                pg8::StaticOrder S; if (sub == 0) S.init(MTOK, cd ? CD_N - 256 : AB_N, (int)gridDim.x, (int)blockIdx.x); else S.init_tail(MTOK, CD_N / 256 - 1, (int)gridDim.x, (int)blockIdx.x);
                pg8::EpiIn E{(bf16_t*)(P->ws + WS_PROJ), cd ? CD_N : AB_N, (const float*)(P->ws + WS_SSQ), cd,
                             cd ? P->diff_q_gain + lj * 64 : P->moba_q_gain + lj * 64, cd ? P->diff_k_gain + lj * 64 : P->moba_k_gain + lj * 64,
                             cd ? P->swa_q_gain + lj * 64 : P->fox_q_gain + lj * 64, cd ? P->swa_k_gain + lj * 64 : P->fox_k_gain + lj * 64,
                             (float*)(P->ws + WS_KMEAN), (LAS float*)(lds + LDS_MISC)};
                { const int t = opaque_tid();
                  if (t < 256) { const float* gp = t < 64 ? E.gq0 : t < 128 ? E.gk0 : t < 192 ? E.gq1 : E.gk1; ((LAS float*)(lds + LDS_MISC + 8192))[t] = gp[t & 63]; }
                  __syncthreads(); }
                if (EN & 2) pg8::gemm_phase<pg8::EpiIn, pg8::StaticOrder, true, true>(lds, g, S, E);
                if (sub == 0) { if (EN & 4) if (!cd) fgate_pass(P, lj, lds); }
                else {
                    const int nmine = ((int)blockIdx.x < MTOK / 256) ? (MTOK / 256 - 1 - (int)blockIdx.x) / (int)gridDim.x + 1 : 0;
                    asm volatile("s_waitcnt vmcnt(0)" ::: "memory");
                    __syncthreads();
                    if (nmine > 0 && threadIdx.x == 0) { __builtin_amdgcn_fence(__ATOMIC_RELEASE, "agent"); asm volatile("s_waitcnt vmcnt(0)" ::: "memory"); (void)xb_add(ctl + 64 * (1 + layer) + 32, (unsigned)nmine); }
                }
            }
            if (sub == 1) {
                asm volatile("" : "+s"(P));
                phase_attn(P, layer, lds, ctl + 64 * (1 + layer));
            } else if (sub == 2) {
                pg8::Gemm g{(const bf16_t*)(P->ws + WS_Y), (const bf16_t*)(P->ws + WS_WT_OUT) + (size_t)layer * 1024 * 1024, MTOK, DM, DM};
                pg8::StaticOrder S; S.init(MTOK, DM, (int)gridDim.x, (int)blockIdx.x);
                pg8::EpiOut E{P->x, P->out, (bf16_t*)(P->ws + WS_XB), (float*)(P->ws + WS_SSQ), (LAS float*)(lds + LDS_MISC + 8192), layer};
                if (EN & 8) pg8::gemm_phase<pg8::EpiOut, pg8::StaticOrder, true, true>(lds, g, S, E);
            }
        }
        if (ph + 1 < ph_hi) xcd_barrier(bar);
    }
}

extern "C" void kernel_launch(void* const* d_in, const int* in_sizes, int n_in, void* d_out, int out_size, void* d_ws, size_t ws_size, hipStream_t stream) {
    static int grid = 0;
    if (grid == 0) {
        if (n_in != 18 || in_sizes[0] != MTOK * DM || out_size != MTOK * DM || ws_size < WS_END) { fprintf(stderr, "kernel_launch: unexpected shapes (n_in %d, in0 %d, out %d, ws %zu)\n", n_in, n_in > 0 ? in_sizes[0] : -1, out_size, ws_size); grid = -1; return; }
        int dev = 0, cus = 0, per_cu = 0;
        (void)hipGetDevice(&dev); (void)hipDeviceGetAttribute(&cus, hipDeviceAttributeMultiprocessorCount, dev);
        if (hipFuncSetAttribute((const void*)mega_fwd, hipFuncAttributeMaxDynamicSharedMemorySize, LDS_BYTES) != hipSuccess) { fprintf(stderr, "kernel_launch: hipFuncSetAttribute failed\n"); grid = -1; return; }
        if (hipOccupancyMaxActiveBlocksPerMultiprocessor(&per_cu, (const void*)mega_fwd, 512, LDS_BYTES) != hipSuccess || per_cu < 1) { fprintf(stderr, "kernel_launch: occupancy query says %d\n", per_cu); per_cu = 1; }
        (void)hipGetLastError();
        grid = cus;
    }
    if (grid < 0) return;
#if MK_N_LAUNCHES != 1
    (void)hipMemsetAsync((char*)d_ws + WS_CTL, 0, CTL_ZERO_BYTES, stream);
#endif
    Params p{};
    const float** pp = (const float**)&p;
    for (int i = 0; i < 18; ++i) pp[i] = (const float*)d_in[i];
    p.out = (float*)d_out; p.ws = (unsigned char*)d_ws;
#if MK_N_LAUNCHES == 1
    p.ph_lo = 0; p.ph_hi = NPHASE;
    void* args[] = {&p};
    hipError_t e = hipLaunchCooperativeKernel((const void*)mega_fwd, dim3(grid), dim3(512), args, LDS_BYTES, stream);
    if (e != hipSuccess) fprintf(stderr, "cooperative launch failed: %s (grid %d)\n", hipGetErrorString(e), grid);
#else
    for (int ph = 0; ph < NPHASE; ++ph) { p.ph_lo = ph; p.ph_hi = ph + 1; hipLaunchKernelGGL(mega_fwd, dim3(grid), dim3(512), LDS_BYTES, stream, p); }
#endif
}
```
